# Optimizing an MI355X kernel written in HIP

```python
import math
import jax, jax.numpy as jnp
from jax import lax
import numpy as np

D_MODEL = 1024
BATCH = 2
SEQ = 8192
DEPTH = 2

HEAD_DIM = 64
N_MLSTM = 4
N_RET = 4
N_SB = 4
N_SWA_Q = 4
N_SWA_KV = 2
N_BRANCH = 4
W_BRANCH = 4 * HEAD_DIM
W_SWA_KV = N_SWA_KV * HEAD_DIM
CHUNK = 128
BLOCK = 128
WINDOW = 128
CONV_K = 4
D_FF = 4 * D_MODEL
N_BUCKETS = 32
MAX_DIST = 128
ROPE_BASE = 10000.0
RET_DECAY_BASE = 5.0
EPS = 1e-6

MLSTM_WIDTHS = (W_BRANCH, W_BRANCH, W_BRANCH, N_MLSTM, N_MLSTM, W_BRANCH)
RET_WIDTHS = (W_BRANCH, W_BRANCH, W_BRANCH, W_BRANCH)
SB_WIDTHS = (W_BRANCH, W_BRANCH, W_BRANCH)
SWA_WIDTHS = (N_SWA_Q * HEAD_DIM, W_SWA_KV, W_SWA_KV)
GATE_WIDTH = N_BRANCH * D_MODEL
IN_WIDTHS = (sum(MLSTM_WIDTHS), sum(RET_WIDTHS), sum(SB_WIDTHS), sum(SWA_WIDTHS), GATE_WIDTH)
D_IN = sum(IN_WIDTHS)

kernel_name = 'hybrid_gated_mlstm_ret_sb_swa_trunk'


def split_cols(x, widths):
    return jnp.split(x, [int(i) for i in np.cumsum(widths)[:-1]], axis=-1)


def rms_norm(x, g):
    xf = x.astype(jnp.float32)
    y = xf * lax.rsqrt(jnp.mean(xf * xf, axis=-1, keepdims=True) + EPS)
    return (y * g.astype(jnp.float32)).astype(x.dtype)


def to_heads(t, n):
    b, s, _ = t.shape
    return t.reshape(b, s, n, HEAD_DIM).transpose(0, 2, 1, 3)


def from_heads(t):
    b, n, s, d = t.shape
    return t.transpose(0, 2, 1, 3).reshape(b, s, n * d)


def causal_dwconv(u, w, b):
    k, ch = w.shape
    out = lax.conv_general_dilated(u, w[:, None, :], window_strides=(1,), padding=[(k - 1, 0)],
                                   dimension_numbers=('NWC', 'WIO', 'NWC'), feature_group_count=ch)
    return out + b


def rotary(t, positions):
    half = t.shape[-1] // 2
    inv = ROPE_BASE ** (-jnp.arange(half, dtype=jnp.float32) / half)
    ang = positions[:, None, :, None].astype(jnp.float32) * inv
    cos, sin = jnp.cos(ang), jnp.sin(ang)
    t1, t2 = t[..., :half], t[..., half:]
    return jnp.concatenate([t1 * cos - t2 * sin, t1 * sin + t2 * cos], axis=-1)


def t5_bucket(rel):
    n = jnp.maximum(rel, 0)
    max_exact = N_BUCKETS // 2
    nf = jnp.maximum(n, 1).astype(jnp.float32)
    large = max_exact + (jnp.log(nf / max_exact) / math.log(MAX_DIST / max_exact)
                         * (N_BUCKETS - max_exact)).astype(jnp.int32)
    large = jnp.minimum(large, N_BUCKETS - 1)
    return jnp.where(n < max_exact, n, large)


def mlstm(q, k, v, i_pre, f_pre):
    b, h, s, d = q.shape
    shp = (b, h, s // CHUNK, CHUNK)
    qc = (q * d ** -0.5).reshape(shp + (d,))
    kc = k.reshape(shp + (d,))
    vc = v.reshape(shp + (d,))
    ig = i_pre.reshape(shp)
    a = jnp.cumsum(jax.nn.log_sigmoid(f_pre).reshape(shp), axis=-1)
    a_last = a[..., -1]
    causal = jnp.tril(jnp.ones((CHUNK, CHUNK), dtype=bool))
    d_intra = jnp.where(causal, a[..., :, None] - a[..., None, :] + ig[..., None, :], -jnp.inf)
    g_loc = a_last[..., None] - a + ig
    m_loc = jnp.max(g_loc, axis=-1)
    w_loc = jnp.exp(g_loc - m_loc[..., None])
    c_loc = jnp.einsum('bhnsk,bhnsv->bhnkv', kc * w_loc[..., None], vc)
    n_loc = jnp.einsum('bhns,bhnsk->bhnk', w_loc, kc)

    def step(carry, inp):
        c_st, n_st, m_st = carry
        c_l, n_l, m_l, a_l = inp
        m_new = jnp.maximum(a_l + m_st, m_l)
        s_old = jnp.exp(a_l + m_st - m_new)
        s_new = jnp.exp(m_l - m_new)
        c_new = s_old[..., None, None] * c_st + s_new[..., None, None] * c_l
        n_new = s_old[..., None] * n_st + s_new[..., None] * n_l
        return (c_new, n_new, m_new), (c_st, n_st, m_st)

    init = (jnp.zeros((b, h, d, d), jnp.float32), jnp.zeros((b, h, d), jnp.float32),
            jnp.zeros((b, h), jnp.float32))
    xs = tuple(jnp.moveaxis(t, 2, 0) for t in (c_loc, n_loc, m_loc, a_last))
    _, (c_in, n_in, m_in) = lax.scan(step, init, xs)
    c_in = jnp.moveaxis(c_in, 0, 2)
    n_in = jnp.moveaxis(n_in, 0, 2)
    m_in = jnp.moveaxis(m_in, 0, 2)
    m_inter = a + m_in[..., None]
    m_tot = jnp.maximum(m_inter, jnp.max(d_intra, axis=-1))
    s_inter = jnp.exp(m_inter - m_tot)
    p = jnp.exp(d_intra - m_tot[..., None]) * jnp.einsum('bhnld,bhnsd->bhnls', qc, kc)
    num = (s_inter[..., None] * jnp.einsum('bhnlk,bhnkv->bhnlv', qc, c_in)
           + jnp.einsum('bhnls,bhnsv->bhnlv', p, vc))
    den = s_inter * jnp.einsum('bhnlk,bhnk->bhnl', qc, n_in) + jnp.sum(p, axis=-1)
    out = num / jnp.maximum(jnp.abs(den), jnp.exp(-m_tot))[..., None]
    return out.reshape(b, h, s, d)


def retention(q, k, v, log_gamma):
    b, h, s, d = q.shape
    n_c = s // CHUNK

    def chunk(t):
        return jnp.moveaxis(t.reshape(b, h, n_c, CHUNK, d), 2, 0)

    idx = jnp.arange(CHUNK, dtype=jnp.float32)
    lg = log_gamma[:, None]
    rel = idx[:, None] - idx[None, :]
    decay_intra = jnp.where(rel >= 0, jnp.exp(jnp.maximum(rel, 0.0)[None] * lg[..., None]), 0.0)
    decay_q = jnp.exp((idx + 1.0)[None] * lg)
    decay_k = jnp.exp((CHUNK - 1.0 - idx)[None] * lg)
    decay_c = jnp.exp(CHUNK * log_gamma)

    def step(state, inp):
        qc, kc, vc = inp
        sc = jnp.einsum('bhld,bhsd->bhls', qc, kc) * decay_intra
        o = (jnp.einsum('bhls,bhsv->bhlv', sc, vc)
             + jnp.einsum('bhlk,bhkv->bhlv', qc, state) * decay_q[..., None])
        state = decay_c[:, None, None] * state + jnp.einsum('bhsk,bhsv->bhkv', kc * decay_k[..., None], vc)
        return state, o

    _, o = lax.scan(step, jnp.zeros((b, h, d, d), jnp.float32), (chunk(q), chunk(k), chunk(v)))
    return jnp.moveaxis(o, 0, 2).reshape(b, h, s, d)


def stick_breaking(q, k, v):
    b, h, s, d = q.shape
    n_b = s // BLOCK
    scale = d ** -0.5
    qb = jnp.moveaxis(q.reshape(b, h, n_b, BLOCK, d), 2, 0)
    key_pos = jnp.arange(s)

    def one_block(args):
        q_blk, start = args
        z = jnp.einsum('bhtd,bhsd->bhts', q_blk, k) * scale
        before = key_pos[None, :] < (start + jnp.arange(BLOCK))[:, None]
        log_keep = jnp.where(before, jax.nn.log_sigmoid(-z), 0.0)
        between = lax.cumsum(log_keep, axis=3, reverse=True) - log_keep
        weight = jnp.where(before, jnp.exp(jax.nn.log_sigmoid(z) + between), 0.0)
        return jnp.einsum('bhts,bhsd->bhtd', weight, v)

    out = lax.map(one_block, (qb, jnp.arange(n_b) * BLOCK))
    return jnp.moveaxis(out, 0, 2).reshape(b, h, s, d)


def swa_with_sinks(q, k, v, sinks, rel_bias, positions):
    b, hq, s, d = q.shape
    g = k.shape[1]
    r = hq // g
    n_b = s // BLOCK
    qb = q.reshape(b, g, r, n_b, BLOCK, d)

    def band(t):
        tb = t.reshape(b, g, n_b, BLOCK, d)
        prev = jnp.concatenate([jnp.zeros_like(tb[:, :, :1]), tb[:, :, :-1]], axis=2)
        return jnp.concatenate([prev, tb], axis=3)

    kw, vw = band(k), band(v)
    pos_b = positions.reshape(b, n_b, BLOCK)
    pos_prev = jnp.concatenate([pos_b[:, :1] - BLOCK, pos_b[:, :-1]], axis=1)
    pos_k = jnp.concatenate([pos_prev, pos_b], axis=2)
    bucket = t5_bucket(pos_b[..., :, None] - pos_k[..., None, :])
    bias = jnp.moveaxis(rel_bias[bucket].astype(jnp.float32), -1, 1).reshape(b, g, r, n_b, BLOCK, 2 * BLOCK)
    kj = jnp.arange(2 * BLOCK)[None, :]
    dist = (jnp.arange(BLOCK)[:, None] + BLOCK) - kj
    key_abs = (jnp.arange(n_b) * BLOCK - BLOCK)[:, None, None] + kj[None]
    valid = (dist >= 0) & (dist < WINDOW) & (key_abs >= 0)
    logits = jnp.einsum('bgrnid,bgnjd->bgrnij', qb, kw) * d ** -0.5 + bias
    logits = jnp.where(valid, logits, -jnp.inf)
    sink = sinks.reshape(g, r)[None, :, :, None, None, None]
    m = jnp.maximum(jnp.max(logits, axis=-1, keepdims=True), sink)
    p = jnp.exp(logits - m)
    den = jnp.sum(p, axis=-1, keepdims=True) + jnp.exp(sink - m)
    out = jnp.einsum('bgrnij,bgnjd->bgrnid', p / den, vw)
    return out.reshape(b, hq, s, d)


def token_mixer(h, positions, w_in, conv_w, conv_b, gate_b, ret_g, q_g, k_g, sinks, rel_bias,
                w_up, w_out, log_gamma):
    f32 = jnp.float32
    b, s, _ = h.shape
    p_ml, p_ret, p_sb, p_swa, p_gate = split_cols(h @ w_in, IN_WIDTHS)

    mq, mk, mv, mi, mf, mo = split_cols(p_ml, MLSTM_WIDTHS)
    qk = jax.nn.silu(causal_dwconv(jnp.concatenate([mq, mk], axis=-1), conv_w, conv_b))
    mq, mk = jnp.split(qk, 2, axis=-1)
    i_pre = jnp.moveaxis((mi + gate_b[0]).astype(f32), -1, 1)
    f_pre = jnp.moveaxis((mf + gate_b[1]).astype(f32), -1, 1)
    h_ml = mlstm(to_heads(mq, N_MLSTM).astype(f32), to_heads(mk, N_MLSTM).astype(f32),
                 to_heads(mv, N_MLSTM).astype(f32), i_pre, f_pre)
    out_ml = from_heads(h_ml) * jax.nn.sigmoid(mo.astype(f32))

    rq, rk, rv, rg = split_cols(p_ret, RET_WIDTHS)
    rq = rotary(to_heads(rq, N_RET).astype(f32), positions)
    rk = rotary(to_heads(rk, N_RET).astype(f32), positions) * HEAD_DIM ** -0.5
    h_ret = from_heads(retention(rq, rk, to_heads(rv, N_RET).astype(f32), log_gamma))
    h_ret = rms_norm(h_ret.reshape(b, s, N_RET, HEAD_DIM), ret_g.reshape(N_RET, HEAD_DIM)).reshape(b, s, W_BRANCH)
    out_ret = h_ret * jax.nn.silu(rg.astype(f32))

    sq, sk, sv = split_cols(p_sb, SB_WIDTHS)
    out_sb = from_heads(stick_breaking(to_heads(sq, N_SB).astype(f32), to_heads(sk, N_SB).astype(f32),
                                       to_heads(sv, N_SB).astype(f32)))

    aq, ak, av = split_cols(p_swa, SWA_WIDTHS)
    aq = rms_norm(to_heads(aq, N_SWA_Q).astype(f32), q_g)
    ak = rms_norm(to_heads(ak, N_SWA_KV).astype(f32), k_g)
    out_swa = from_heads(swa_with_sinks(aq, ak, to_heads(av, N_SWA_KV).astype(f32),
                                        sinks.astype(f32), rel_bias, positions))

    branches = jnp.stack([out_ml, out_ret, out_sb, out_swa], axis=2).astype(h.dtype)
    up = jnp.einsum('bsnw,nwd->bsnd', branches, w_up)
    gates = jax.nn.sigmoid(p_gate.reshape(b, s, N_BRANCH, D_MODEL))
    merged = jnp.sum(gates * up, axis=2)
    return merged @ w_out


def setup_inputs(seed: int = 0) -> dict:
    key = jax.random.key(seed)
    ks = jax.random.split(key, 20)
    nrm = jax.random.normal
    x = nrm(ks[0], (BATCH, SEQ, D_MODEL), jnp.float32)
    c = nrm(ks[1], (BATCH, D_MODEL), jnp.float32)
    start = jax.random.randint(ks[2], (BATCH, 1), 0, 1024, dtype=jnp.int32)
    positions = (start + jnp.arange(SEQ, dtype=jnp.int32)[None, :]).astype(jnp.int32)
    w_ada = nrm(ks[3], (DEPTH, 2, D_MODEL, 3 * D_MODEL), jnp.float32) * (0.5 * D_MODEL ** -0.5)
    b_ada = nrm(ks[4], (DEPTH, 2, 3 * D_MODEL), jnp.float32) * 0.02
    norm_g = 1.0 + 0.02 * nrm(ks[5], (DEPTH, 2, D_MODEL), jnp.float32)
    w_in = nrm(ks[6], (DEPTH, D_MODEL, D_IN), jnp.float32) * D_MODEL ** -0.5
    mlstm_conv_w = nrm(ks[7], (DEPTH, CONV_K, 2 * W_BRANCH), jnp.float32) * CONV_K ** -0.5
    mlstm_conv_b = 0.02 * nrm(ks[8], (DEPTH, 2 * W_BRANCH), jnp.float32)
    i_bias = 0.1 * nrm(ks[9], (DEPTH, 1, N_MLSTM), jnp.float32)
    f_bias = 3.0 + 3.0 * jax.random.uniform(ks[10], (DEPTH, 1, N_MLSTM), jnp.float32)
    mlstm_gate_b = jnp.concatenate([i_bias, f_bias], axis=1)
    ret_norm_g = 1.0 + 0.02 * nrm(ks[11], (DEPTH, W_BRANCH), jnp.float32)
    swa_q_norm_g = 1.0 + 0.02 * nrm(ks[12], (DEPTH, HEAD_DIM), jnp.float32)
    swa_k_norm_g = 1.0 + 0.02 * nrm(ks[13], (DEPTH, HEAD_DIM), jnp.float32)
    swa_sinks = nrm(ks[14], (DEPTH, N_SWA_Q), jnp.float32)
    rel_bias = 0.5 * nrm(ks[15], (N_BUCKETS, N_SWA_Q), jnp.float32)
    w_up = nrm(ks[16], (DEPTH, N_BRANCH, W_BRANCH, D_MODEL), jnp.float32) * W_BRANCH ** -0.5
    w_out = nrm(ks[17], (DEPTH, D_MODEL, D_MODEL), jnp.float32) * D_MODEL ** -0.5
    w_ff1 = nrm(ks[18], (DEPTH, D_MODEL, D_FF), jnp.float32) * D_MODEL ** -0.5
    w_ff2 = nrm(ks[19], (DEPTH, D_FF, D_MODEL), jnp.float32) * D_FF ** -0.5
    return {'x': x, 'c': c, 'positions': positions, 'w_ada': w_ada, 'b_ada': b_ada, 'norm_g': norm_g,
            'w_in': w_in, 'mlstm_conv_w': mlstm_conv_w, 'mlstm_conv_b': mlstm_conv_b,
            'mlstm_gate_b': mlstm_gate_b, 'ret_norm_g': ret_norm_g, 'swa_q_norm_g': swa_q_norm_g,
            'swa_k_norm_g': swa_k_norm_g, 'swa_sinks': swa_sinks, 'rel_bias': rel_bias, 'w_up': w_up,
            'w_out': w_out, 'w_ff1': w_ff1, 'w_ff2': w_ff2}


def reference(x, c, positions, w_ada, b_ada, norm_g, w_in, mlstm_conv_w, mlstm_conv_b, mlstm_gate_b,
              ret_norm_g, swa_q_norm_g, swa_k_norm_g, swa_sinks, rel_bias, w_up, w_out, w_ff1, w_ff2):
    log_gamma = jnp.log(1.0 - jnp.exp2(-(RET_DECAY_BASE + jnp.arange(N_RET, dtype=jnp.float32))))
    c_act = jax.nn.silu(c)
    for l in range(DEPTH):
        mod = jnp.einsum('bd,jde->bje', c_act, w_ada[l]) + b_ada[l]
        shift1, scale1, gate1 = jnp.split(mod[:, 0], 3, axis=-1)
        shift2, scale2, gate2 = jnp.split(mod[:, 1], 3, axis=-1)
        h = rms_norm(x, norm_g[l, 0]) * (1.0 + scale1[:, None, :]) + shift1[:, None, :]
        mix = token_mixer(h, positions, w_in[l], mlstm_conv_w[l], mlstm_conv_b[l], mlstm_gate_b[l],
                          ret_norm_g[l], swa_q_norm_g[l], swa_k_norm_g[l], swa_sinks[l], rel_bias,
                          w_up[l], w_out[l], log_gamma)
        x = x + gate1[:, None, :] * mix.astype(x.dtype)
        h2 = rms_norm(x, norm_g[l, 1]) * (1.0 + scale2[:, None, :]) + shift2[:, None, :]
        ff = jnp.square(jax.nn.relu(h2 @ w_ff1[l])) @ w_ff2[l]
        x = x + gate2[:, None, :] * ff
    return x
```

```cpp
#include <hip/hip_runtime.h>
#include <cstdio>
#include <cstdint>
#ifndef PROBE_MASK
#define PROBE_MASK 0
#endif

typedef unsigned short bf16_t;
typedef unsigned char u8;
#define LAS __attribute__((address_space(3)))
#define GAS __attribute__((address_space(1)))

constexpr int B_ = 2, S_ = 8192, D_ = 1024, L_ = 2, T_ = B_ * S_;
constexpr int DIN = 7432, NIN = 7424, NINP = 7680, NPM = 3328, NGT = 4096, DFF = 4096;
constexpr int NCH = 64;
constexpr int C_MQ = 0, C_MK = 256, C_MV = 512, C_MO = 768, C_RQ = 1024, C_RK = 1280, C_RV = 1536, C_RG = 1792,
              C_SQ = 2048, C_SK = 2304, C_SV = 2560, C_AQ = 2816, C_AK = 3072, C_AV = 3200;
constexpr size_t MiB = 1u << 20;
constexpr size_t WS_CTL = 0, CTL_ZERO_BYTES = 1 * MiB;
constexpr size_t WS_SSQ = 256 * 1024;
constexpr size_t WS_BIAS = 512 * 1024;
constexpr int BSTR = NINP + DFF;
constexpr size_t WS_MOD = 1 * MiB;
constexpr size_t WS_GS = 1 * MiB + 128 * 1024;
constexpr size_t WS_IF = 1 * MiB + 256 * 1024;
constexpr size_t WS_ST_ML = 2 * MiB, WS_ST_RT = 10 * MiB;
constexpr size_t WS_SMALL = 18 * MiB;
constexpr size_t WS_WIN = 19 * MiB;
constexpr size_t WS_WUP = WS_WIN + (size_t)NINP * 1024 * 2;
constexpr size_t WS_WOUT = WS_WUP + 2 * MiB;
constexpr size_t WS_W1 = WS_WOUT + 2 * MiB;
constexpr size_t WS_W2 = WS_W1 + 8 * MiB;
constexpr size_t WS_H = 54 * MiB;
constexpr size_t WS_PM = 86 * MiB;
constexpr size_t WS_GT = 190 * MiB;
constexpr size_t WS_HID = 86 * MiB;
constexpr size_t WS_H2 = 214 * MiB;
static_assert(WS_W2 + 8 * MiB <= WS_H, "weights fit below H");
constexpr int SM_NL = 0, SM_ML = 512 * 64, SM_AL = SM_ML + 512, SM_MI = SM_AL + 512;
constexpr int CW_BAR = 1024;

__device__ __forceinline__ float bf2f(bf16_t u) { return __uint_as_float(((unsigned)u) << 16); }
__device__ __forceinline__ bf16_t f2bf(float f) { unsigned u = __float_as_uint(f); return (bf16_t)((u + 0x7fffu + ((u >> 16) & 1u)) >> 16); }
__device__ __forceinline__ unsigned pk2(float lo, float hi) { return (unsigned)f2bf(lo) | ((unsigned)f2bf(hi) << 16); }
__device__ __forceinline__ float sigmoidf_(float x) { return 1.0f / (1.0f + expf(-x)); }
__device__ __forceinline__ float siluf_(float x) { return x / (1.0f + expf(-x)); }
__device__ __forceinline__ float logsigmoidf_(float x) { return fminf(x, 0.0f) - log1pf(expf(-fabsf(x))); }
__device__ __forceinline__ float wave_sum(float v) {
#pragma unroll
    for (int o = 1; o < 64; o <<= 1) v += __shfl_xor(v, o);
    return v;
}

typedef float f32x2_t_ __attribute__((ext_vector_type(2))); typedef __bf16 bf16x2_t_ __attribute__((ext_vector_type(2)));
__device__ __forceinline__ unsigned cvt_pk_visible(float lo, float hi) { f32x2_t_ v = {lo, hi}; bf16x2_t_ b = __builtin_convertvector(v, bf16x2_t_); return __builtin_bit_cast(unsigned, b); }
namespace pg8 {
typedef short bf16x8 __attribute__((ext_vector_type(8)));
typedef float f32x4 __attribute__((ext_vector_type(4)));
typedef unsigned u32x4 __attribute__((ext_vector_type(4)));
typedef unsigned u32x2 __attribute__((ext_vector_type(2)));
constexpr int BM = 256, BK = 64, HALF = 128, HTB = HALF * BK * 2, STAGE_BYTES = 8 * HTB, NXCD = 8, WGM = 8;
__host__ __device__ __forceinline__ int lds_byte(int r, int c) { const int st = (r >> 4) * 2 + (c >> 5), rr = r & 15, cc = c & 31, ob = rr * 64 + cc * 2; return st * 1024 + (ob ^ (((ob >> 9) & 1) << 5)); }
__host__ __device__ __forceinline__ void stage_rc(int b, int& R, int& C) { const int st = b / 1024, sb = b % 1024, swz = sb ^ (((sb >> 9) & 1) << 5); R = (st >> 1) * 16 + swz / 64; C = (st & 1) * 32 + (swz % 64) / 2; }
__host__ __device__ __forceinline__ int perm32(int rho) { const int n = rho >> 4, i = rho & 15; return 8 * (i >> 2) + 4 * n + (i & 3); }

struct Unit { int pm, pn, z; };
struct Gemm { const bf16_t* A; const bf16_t* Bt; };

struct StaticOrder {
    int nM, nN, nwg, G, c;
    __device__ void init(int M, int N, int G_, int c_) { nM = M / BM; nN = N / BM; nwg = nM * nN; G = G_; c = c_; }
    __device__ bool tile(long Lx, Unit& u) const {
        if (Lx >= nwg) return false;
        int wgid = (int)Lx; { const int q = nwg / NXCD, r = nwg % NXCD, xcd = wgid % NXCD, off = wgid / NXCD; wgid = (xcd < r ? xcd * (q + 1) : r * (q + 1) + (xcd - r) * q) + off; }
        const int nig = WGM * nN, gid = wgid / nig, fm = gid * WGM, gsz = (nM - fm) < WGM ? (nM - fm) : WGM;
        u.pm = fm + ((wgid % nig) % gsz); u.pn = (wgid % nig) / gsz; u.z = 0; return true;
    }
    __device__ bool next(int i, Unit& u) const { return tile((long)i * G + c, u); }
    template <int LDA, int KK> __device__ const char* a_base(const Gemm& g, const Unit& u) const { return (const char*)g.A + (size_t)u.pm * BM * LDA * 2; }
    template <int LDA, int KK> __device__ const char* b_base(const Gemm& g, const Unit& u) const { return (const char*)g.Bt + (size_t)u.pn * BM * KK * 2; }
};
struct UpOrder {
    StaticOrder so;
    __device__ bool next(int i, Unit& u) const { if (!so.tile((long)(i >> 2) * so.G + so.c, u)) return false; u.z = i & 3; return true; }
    template <int LDA, int KK> __device__ const char* a_base(const Gemm& g, const Unit& u) const { const int ac = (u.z == 0) ? C_MO : (u.z == 1) ? C_RG : (u.z == 2) ? C_SQ : C_AQ; return (const char*)g.A + ((size_t)u.pm * BM * LDA + ac) * 2; }
    template <int LDA, int KK> __device__ const char* b_base(const Gemm& g, const Unit& u) const { return (const char*)g.Bt + ((size_t)u.z * 1024 + (size_t)u.pn * BM) * KK * 2; }
};

__device__ __forceinline__ unsigned cvt_pk_bf16(float lo, float hi) { return cvt_pk_visible(lo, hi); }

struct EpiIn {
    static constexpr bool PERM = true;
    unsigned char* ws; const float* gate_b; int l;
    __device__ __forceinline__ void operator()(const f32x4 (&acc)[2][2][4][2], const Unit& u, int wr, int wc, int fr, int fq) const {
        bf16_t* PM = (bf16_t*)(ws + WS_PM); u8* GT = (u8*)(ws + WS_GT); float* IF = (float*)(ws + WS_IF); const float* ssq = (const float*)(ws + WS_SSQ) + (size_t)(l * 2) * T_; const float* bias = (const float*)(ws + WS_BIAS) + (size_t)l * B_ * BSTR;
        const int row0 = u.pm * BM + wr * 64 + fr, cl0 = wc * 32 + 8 * fq; const int b = (u.pm * BM) / S_;
        const float* bp = bias + (size_t)b * BSTR + u.pn * BM + cl0;
        if (u.pn == 29) {
            if (wc == 0 && fq == 0) { const f32x4 b0 = *(const f32x4*)bp + *(const f32x4*)gate_b, b1 = *(const f32x4*)(bp + 4) + *(const f32x4*)(gate_b + 4);
#pragma unroll
                for (int ai = 0; ai < 2; ++ai)
#pragma unroll
                    for (int m = 0; m < 4; ++m) { const int r = row0 + ai * HALF + m * 16; const float rs = 1.0f / sqrtf(ssq[r] * (1.0f / D_) + 1e-6f);
                        *(f32x4*)(IF + (size_t)r * 8) = acc[ai][0][m][0] * rs + b0; *(f32x4*)(IF + (size_t)r * 8 + 4) = acc[ai][0][m][1] * rs + b1; } }
            return;
        }
        float rs[2][4];
#pragma unroll
        for (int ai = 0; ai < 2; ++ai)
#pragma unroll
            for (int m = 0; m < 4; ++m) rs[ai][m] = 1.0f / sqrtf(ssq[row0 + ai * HALF + m * 16] * (1.0f / D_) + 1e-6f);
        if (u.pn < 13) {
            const int col0 = u.pn * BM + cl0;
#pragma unroll
            for (int bj = 0; bj < 2; ++bj) { const f32x4 b0 = *(const f32x4*)(bp + bj * HALF), b1 = *(const f32x4*)(bp + bj * HALF + 4);
#pragma unroll
                for (int ai = 0; ai < 2; ++ai)
#pragma unroll
                    for (int m = 0; m < 4; ++m) { const f32x4 v0 = acc[ai][bj][m][0] * rs[ai][m] + b0, v1 = acc[ai][bj][m][1] * rs[ai][m] + b1;
                        u32x4 w; w.x = cvt_pk_bf16(v0[0], v0[1]); w.y = cvt_pk_bf16(v0[2], v0[3]); w.z = cvt_pk_bf16(v1[0], v1[1]); w.w = cvt_pk_bf16(v1[2], v1[3]);
                        *(u32x4*)(PM + (size_t)(row0 + ai * HALF + m * 16) * NPM + col0 + bj * HALF) = w; }
                asm volatile("" ::: "memory"); }
        } else {
            const int col0 = (u.pn - 13) * BM + cl0;
#pragma unroll
            for (int bj = 0; bj < 2; ++bj) { const f32x4 b0 = *(const f32x4*)(bp + bj * HALF), b1 = *(const f32x4*)(bp + bj * HALF + 4);
#pragma unroll
                for (int ai = 0; ai < 2; ++ai)
#pragma unroll
                    for (int m = 0; m < 4; ++m) { unsigned q[8];
#pragma unroll
                        for (int j = 0; j < 4; ++j) { const float s0 = __builtin_amdgcn_rcpf(1.0f + __expf(-(acc[ai][bj][m][0][j] * rs[ai][m] + b0[j]))), s1 = __builtin_amdgcn_rcpf(1.0f + __expf(-(acc[ai][bj][m][1][j] * rs[ai][m] + b1[j])));
                            q[j] = (unsigned)(s0 * 255.0f + 0.5f); q[4 + j] = (unsigned)(s1 * 255.0f + 0.5f); }
                        u32x2 w; w.x = q[0] | (q[1] << 8) | (q[2] << 16) | (q[3] << 24); w.y = q[4] | (q[5] << 8) | (q[6] << 16) | (q[7] << 24);
                        *(u32x2*)(GT + (size_t)(row0 + ai * HALF + m * 16) * NGT + col0 + bj * HALF) = w; }
                asm volatile("" ::: "memory"); }
        }
    }
};
struct EpiUp {
    static constexpr bool PERM = true;
    bf16_t* H; const u8* GT; bool dry;
    __device__ __forceinline__ void operator()(const f32x4 (&acc)[2][2][4][2], const Unit& u, int wr, int wc, int fr, int fq) const {
        const int row0 = u.pm * BM + wr * 64 + fr, col0 = u.pn * BM + wc * 32 + 8 * fq;
#pragma unroll
        for (int ai = 0; ai < 2; ++ai)
#pragma unroll
            for (int m = 0; m < 4; ++m) { const size_t r = (size_t)(row0 + ai * HALF + m * 16);
#pragma unroll
                for (int bj = 0; bj < 2; ++bj) {
                    const u32x2 gq = *(const u32x2*)(GT + r * NGT + u.z * 1024 + col0 + bj * HALF);
                    bf16_t* hp = H + r * D_ + col0 + bj * HALF;
                    float o[8];
#pragma unroll
                    for (int j = 0; j < 8; ++j) { const unsigned gb = ((j < 4 ? gq.x : gq.y) >> (8 * (j & 3))) & 0xffu; o[j] = (float)gb * (1.0f / 255.0f) * acc[ai][bj][m][j >> 2][j & 3]; }
                    if (u.z != 0) { const u32x4 old = *(const u32x4*)hp;
#pragma unroll
                        for (int j = 0; j < 4; ++j) { o[2 * j] += __uint_as_float(old[j] << 16); o[2 * j + 1] += __uint_as_float(old[j] & 0xffff0000u); } }
                    u32x4 w; w.x = cvt_pk_bf16(o[0], o[1]); w.y = cvt_pk_bf16(o[2], o[3]); w.z = cvt_pk_bf16(o[4], o[5]); w.w = cvt_pk_bf16(o[6], o[7]);
                    if (!dry) *(u32x4*)hp = w; }
                if (m & 1) asm volatile("" ::: "memory"); }
    }
};
struct EpiRes {
    static constexpr bool PERM = false;
    const float* xin; float* xout; const float* gate; const float* gs; bf16_t* An; float* ssq; bool dry;
    __device__ __forceinline__ void operator()(const f32x4 (&acc)[2][2][4][2], const Unit& u, int wr, int wc, int fr, int fq) const {
        const int row0 = u.pm * BM + wr * 64 + fr, col0 = u.pn * BM + wc * 32 + 4 * fq; const int b = (u.pm * BM) / S_;
        float ss[2][4];
#pragma unroll
        for (int ai = 0; ai < 2; ++ai)
#pragma unroll
            for (int m = 0; m < 4; ++m) ss[ai][m] = 0.f;
#pragma unroll
        for (int bj = 0; bj < 2; ++bj)
#pragma unroll
            for (int n = 0; n < 2; ++n) { const int cc = col0 + bj * HALF + n * 16;
                const f32x4 gv = *(const f32x4*)(gate + (size_t)b * 6144 + cc); const f32x4 sv = gs ? *(const f32x4*)(gs + (size_t)b * 1024 + cc) : (f32x4){0.f, 0.f, 0.f, 0.f};
#pragma unroll
                for (int ai = 0; ai < 2; ++ai) {
#pragma unroll
                    for (int m = 0; m < 4; ++m) { const size_t off = (size_t)(row0 + ai * HALF + m * 16) * D_ + cc;
                        const f32x4 xi = *(const f32x4*)(xin + off); const f32x4 xo = xi + gv * acc[ai][bj][m][n];
                        if (!dry) *(f32x4*)(xout + off) = xo;
                        if (gs) { ss[ai][m] += (xo[0] * xo[0] + xo[1] * xo[1]) + (xo[2] * xo[2] + xo[3] * xo[3]); const f32x4 a4 = xo * sv;
                            u32x2 w; w.x = cvt_pk_bf16(a4[0], a4[1]); w.y = cvt_pk_bf16(a4[2], a4[3]); if (!dry) *(u32x2*)(An + off) = w; } } }
                asm volatile("" ::: "memory"); }
        if (gs) {
#pragma unroll
            for (int ai = 0; ai < 2; ++ai)
#pragma unroll
                for (int m = 0; m < 4; ++m) { float t = ss[ai][m]; t += __shfl_xor(t, 16); t += __shfl_xor(t, 32); if (fq == 0 && !dry) atomicAdd(ssq + row0 + ai * HALF + m * 16, t); } }
    }
};
struct EpiFF1 {
    static constexpr bool PERM = true;
    bf16_t* HID; const float* ssq; const float* bias;
    __device__ __forceinline__ void operator()(const f32x4 (&acc)[2][2][4][2], const Unit& u, int wr, int wc, int fr, int fq) const {
        const int row0 = u.pm * BM + wr * 64 + fr, col0 = u.pn * BM + wc * 32 + 8 * fq; const int b = (u.pm * BM) / S_;
        f32x4 bv[2][2];
#pragma unroll
        for (int bj = 0; bj < 2; ++bj)
#pragma unroll
            for (int n = 0; n < 2; ++n) bv[bj][n] = *(const f32x4*)(bias + (size_t)b * BSTR + col0 + bj * HALF + 4 * n);
#pragma unroll
        for (int ai = 0; ai < 2; ++ai)
#pragma unroll
            for (int m = 0; m < 4; ++m) { const int r = row0 + ai * HALF + m * 16; const float rs = 1.0f / sqrtf(ssq[r] * (1.0f / D_) + 1e-6f); bf16_t* rowp = HID + (size_t)r * DFF + col0;
#pragma unroll
                for (int bj = 0; bj < 2; ++bj) { f32x4 v0 = acc[ai][bj][m][0] * rs + bv[bj][0], v1 = acc[ai][bj][m][1] * rs + bv[bj][1];
#pragma unroll
                    for (int j = 0; j < 4; ++j) { const float a = fmaxf(v0[j], 0.f), c = fmaxf(v1[j], 0.f); v0[j] = a * a; v1[j] = c * c; }
                    u32x4 w; w.x = cvt_pk_bf16(v0[0], v0[1]); w.y = cvt_pk_bf16(v0[2], v0[3]); w.z = cvt_pk_bf16(v1[0], v1[1]); w.w = cvt_pk_bf16(v1[2], v1[3]);
                    *(u32x4*)(rowp + bj * HALF) = w; } }
    }
};

template <int LDA, int KK, bool ALIGN_EPI = true, class Epi, class Sched>
__device__ __forceinline__ void gemm_phase(LAS unsigned char* lds, const Gemm g, const Sched& S, const Epi& E) {
    int tid = threadIdx.x; asm volatile("" : "+v"(tid));
    const int wid = __builtin_amdgcn_readfirstlane(tid >> 6), lane = tid & 63, wr = wid >> 2, wc = wid & 3, fr = lane & 15, fq = lane >> 4;
    constexpr int K = KK, nt = K / BK, lda = LDA;
    unsigned voffA[2], voffB[2];
#pragma unroll
    for (int i = 0; i < 2; ++i) { int R, C; stage_rc(tid * 16 + i * 8192, R, C); const int Rb = Epi::PERM ? ((R & ~31) + perm32(R & 31)) : R;
        voffA[i] = (unsigned)(R * lda + C) * 2u; voffB[i] = (unsigned)(Rb * K + C) * 2u; }
    constexpr size_t kstep = (size_t)(BK * 2);
    constexpr size_t hstepA = (size_t)HALF * lda * 2, hstepB = (size_t)HALF * K * 2;
    const unsigned ldsw = (unsigned)wid * 1024u;
    const int aoff = lds_byte(wr * 64 + fr, fq * 8), boff = lds_byte(wc * 32 + fr, fq * 8);
#define PG8_SA(b, h) (((b) * 2 + (h)) * HTB)
#define PG8_SB(b, h) ((4 + (b) * 2 + (h)) * HTB)
#define PG8_STAGE(bufoff, gbase, voff) do { _Pragma("unroll") for (int _i = 0; _i < 2; ++_i) \
        __builtin_amdgcn_global_load_lds((const unsigned*)((const char*)(gbase) + (voff)[_i]), (LAS unsigned*)(lds + (bufoff) + ldsw + _i * 8192), 16, 0, 0); } while (0)
#define PG8_LDA(dst, b, h) do { _Pragma("unroll") for (int m = 0; m < 4; ++m) _Pragma("unroll") for (int k = 0; k < 2; ++k) dst[m][k] = *(const LAS bf16x8*)(lds + PG8_SA(b, h) + aoff + m * 2048 + k * 1024); } while (0)
#define PG8_LDB(dst, b, h) do { _Pragma("unroll") for (int n = 0; n < 2; ++n) _Pragma("unroll") for (int k = 0; k < 2; ++k) dst[n][k] = *(const LAS bf16x8*)(lds + PG8_SB(b, h) + boff + n * 2048 + k * 1024); } while (0)
#define PG8_MMA(ai, bj, At, Bt) do { __builtin_amdgcn_s_setprio(1); _Pragma("unroll") for (int m = 0; m < 4; ++m) _Pragma("unroll") for (int n = 0; n < 2; ++n) _Pragma("unroll") for (int k = 0; k < 2; ++k) \
        acc[ai][bj][m][n] = __builtin_amdgcn_mfma_f32_16x16x32_bf16(Bt[n][k], At[m][k], acc[ai][bj][m][n], 0, 0, 0); __builtin_amdgcn_s_setprio(0); } while (0)
#define PG8_WAIT_V(n) asm volatile("s_waitcnt vmcnt(" #n ")" ::: "memory")
#define PG8_WAIT_L(n) asm volatile("s_waitcnt lgkmcnt(" #n ")" ::: "memory")
#define PG8_BAR __builtin_amdgcn_s_barrier()
#define PG8_SCHED __builtin_amdgcn_sched_barrier(0)
    Unit cur, nxt; int ui = 0;
    if (!S.next(0, cur)) return;
    f32x4 acc[2][2][4][2];
#pragma unroll
    for (int a = 0; a < 2; ++a)
#pragma unroll
        for (int b = 0; b < 2; ++b)
#pragma unroll
            for (int m = 0; m < 4; ++m)
#pragma unroll
                for (int n = 0; n < 2; ++n) acc[a][b][m][n] = (f32x4){0.f, 0.f, 0.f, 0.f};
    bf16x8 At[4][2], B0[2][2], B1[2][2];
    const char* cA = S.template a_base<LDA, KK>(g, cur); const char* cB = S.template b_base<LDA, KK>(g, cur);
    PG8_STAGE(PG8_SB(0, 0), cB, voffB); PG8_STAGE(PG8_SB(0, 1), cB + hstepB, voffB); PG8_STAGE(PG8_SA(0, 0), cA, voffA); PG8_STAGE(PG8_SA(0, 1), cA + hstepA, voffA);
    if (wr == 1) PG8_BAR;
    PG8_WAIT_V(2); PG8_BAR;
    PG8_STAGE(PG8_SB(1, 0), cB + kstep, voffB); PG8_STAGE(PG8_SA(1, 0), cA + kstep, voffA); PG8_STAGE(PG8_SB(1, 1), cB + hstepB + kstep, voffB);
    PG8_WAIT_V(6); PG8_BAR;
    for (;;) {
        const bool has_next = S.next(ui + 1, nxt);
        const char* nA = has_next ? S.template a_base<LDA, KK>(g, nxt) : cA; const char* nB = has_next ? S.template b_base<LDA, KK>(g, nxt) : cB;
#pragma nounroll
        for (int t = 0; t < nt; t += 2) {
            const bool last = (t == nt - 2);
            const char* a1 = cA + (size_t)(t + 1) * kstep;
            const char* a2 = last ? nA : cA + (size_t)(t + 2) * kstep; const char* b2 = last ? nB : cB + (size_t)(t + 2) * kstep;
            const char* a3 = a2 + kstep; const char* b3 = b2 + kstep;
            PG8_LDB(B0, 0, 0); PG8_LDB(B1, 0, 1); PG8_SCHED; PG8_LDA(At, 0, 0); PG8_STAGE(PG8_SA(1, 1), a1 + hstepA, voffA);
            PG8_WAIT_V(8); PG8_WAIT_L(0); PG8_BAR; PG8_MMA(0, 0, At, B0); PG8_MMA(0, 1, At, B1); PG8_BAR; PG8_SCHED;
            PG8_LDA(At, 0, 1); PG8_STAGE(PG8_SB(0, 0), b2, voffB); PG8_STAGE(PG8_SB(0, 1), b2 + hstepB, voffB); PG8_STAGE(PG8_SA(0, 0), a2, voffA);
            PG8_WAIT_V(8); PG8_WAIT_L(0); PG8_BAR; PG8_MMA(1, 0, At, B0); PG8_MMA(1, 1, At, B1); PG8_BAR; PG8_SCHED;
            PG8_LDB(B0, 1, 0); PG8_LDB(B1, 1, 1); PG8_SCHED; PG8_LDA(At, 1, 0); PG8_STAGE(PG8_SA(0, 1), a2 + hstepA, voffA);
            PG8_WAIT_V(8); PG8_WAIT_L(0); PG8_BAR; PG8_MMA(0, 0, At, B0); PG8_MMA(0, 1, At, B1); PG8_BAR; PG8_SCHED;
            PG8_LDA(At, 1, 1); PG8_STAGE(PG8_SB(1, 0), b3, voffB); PG8_STAGE(PG8_SB(1, 1), b3 + hstepB, voffB); PG8_STAGE(PG8_SA(1, 0), a3, voffA);
            PG8_WAIT_V(8); PG8_WAIT_L(0); PG8_BAR; PG8_MMA(1, 0, At, B0); PG8_MMA(1, 1, At, B1); PG8_BAR; PG8_SCHED;
        }
        if constexpr (ALIGN_EPI) { if (wr == 0) PG8_BAR; }
        E(acc, cur, wr, wc, fr, fq);
        if (!has_next) break;
#pragma unroll
        for (int a = 0; a < 2; ++a)
#pragma unroll
            for (int b = 0; b < 2; ++b)
#pragma unroll
                for (int m = 0; m < 4; ++m)
#pragma unroll
                    for (int n = 0; n < 2; ++n) acc[a][b][m][n] = (f32x4){0.f, 0.f, 0.f, 0.f};
        cur = nxt; cA = nA; cB = nB; ++ui;
        if constexpr (ALIGN_EPI) { if (wr == 1) PG8_BAR; }
    }
    PG8_WAIT_V(0);
    if constexpr (!ALIGN_EPI) { if (wr == 0) PG8_BAR; }
    PG8_BAR;
#undef PG8_SA
#undef PG8_SB
#undef PG8_STAGE
#undef PG8_LDA
#undef PG8_LDB
#undef PG8_MMA
#undef PG8_WAIT_V
#undef PG8_WAIT_L
#undef PG8_BAR
#undef PG8_SCHED
}
}

#define XB_TMO      128
#define XB_XCNT(j)  (256  + 64 * (j))
#define XB_XSUB(j)  (1280 + 64 * (j))
#define XB_XGEN(j)  (2304 + 64 * (j))
#define XB_TOP      3328
#define XB_TOPGEN   3392
#define XCD_BAR_WORDS 3456
#define XB_SPIN_CAP (1u << 25)
__device__ __forceinline__ unsigned xb_ld(unsigned* p)              { return __hip_atomic_load(p, __ATOMIC_RELAXED, __HIP_MEMORY_SCOPE_AGENT); }
__device__ __forceinline__ unsigned xb_add(unsigned* p, unsigned v) { return __hip_atomic_fetch_add(p, v, __ATOMIC_RELAXED, __HIP_MEMORY_SCOPE_AGENT); }
__device__ __forceinline__ unsigned xb_xcc_id() { return (unsigned)__builtin_amdgcn_s_getreg((3 << 11) | 20) & 0xFu; }
#define XB_SPIN(cond, bar) do { unsigned _sp = 0; while (cond) { __builtin_amdgcn_s_sleep(1); \
    if ((++_sp & 255u) == 0u) { if (xb_ld(&(bar)[XB_TMO])) break; if (_sp > XB_SPIN_CAP) { atomicAdd(&(bar)[XB_TMO], 1u); break; } } } } while (0)
struct XcdBarrier { unsigned* bar; unsigned x; volatile LAS unsigned* st; };
__device__ __forceinline__ XcdBarrier xcd_barrier_post(unsigned* bar, volatile LAS unsigned* st) {
    XcdBarrier b; b.bar = bar; b.x = xb_xcc_id(); b.st = st;
    if (threadIdx.x == 0) (void)xb_add(&bar[XB_XCNT(b.x)], 1u);
    return b;
}
__device__ __forceinline__ void xcd_barrier_complete(unsigned* bar, unsigned x, unsigned& nloc, unsigned& nx) {
    const unsigned G = gridDim.x * gridDim.y * gridDim.z;
    unsigned sum, cnt, mine, sp = 0u;
    for (;;) {
        sum = 0u; cnt = 0u; mine = 0u;
#pragma unroll
        for (unsigned j = 0; j < 16; ++j) { const unsigned c = xb_ld(&bar[XB_XCNT(j)]); sum += c; cnt += (c > 0u) ? 1u : 0u; mine = (j == x) ? c : mine; }
        if (sum == G) break;
        __builtin_amdgcn_s_sleep(1);
        if ((++sp & 255u) == 0u) { if (xb_ld(&bar[XB_TMO])) break; if (sp > XB_SPIN_CAP) { atomicAdd(&bar[XB_TMO], 1u); break; } }
    }
    nloc = mine > 0u ? mine : 1u; nx = cnt > 0u ? cnt : 1u;
}
__device__ __forceinline__ void xcd_barrier(const XcdBarrier& b) {
    asm volatile("s_waitcnt vmcnt(0)" ::: "memory");
    __syncthreads();
    if (threadIdx.x == 0) {
        unsigned* bar = b.bar;
        __builtin_amdgcn_s_waitcnt(0);
        unsigned nloc = b.st[0], nx = b.st[1];
        if (nloc == 0u) { xcd_barrier_complete(bar, b.x, nloc, nx); b.st[0] = nloc; b.st[1] = nx; }
        const unsigned old = xb_add(&bar[XB_XSUB(b.x)], 1u);
        const unsigned gen = old / nloc;
        if (old + 1u == (gen + 1u) * nloc) {
            __builtin_amdgcn_fence(__ATOMIC_RELEASE, "agent");
            asm volatile("s_waitcnt vmcnt(0)" ::: "memory");
            const unsigned og = xb_add(&bar[XB_TOP], 1u);
            const unsigned tg = og / nx;
            if (og + 1u == (tg + 1u) * nx) xb_add(&bar[XB_TOPGEN], 1u);
            else XB_SPIN(xb_ld(&bar[XB_TOPGEN]) == tg, bar);
            __builtin_amdgcn_fence(__ATOMIC_ACQUIRE, "agent");
            xb_add(&bar[XB_XGEN(b.x)], 1u);
            asm volatile("s_waitcnt vmcnt(0)" ::: "memory");
        } else {
            XB_SPIN(xb_ld(&bar[XB_XGEN(b.x)]) == gen, bar);
            __builtin_amdgcn_fence(__ATOMIC_ACQUIRE, "agent");
            asm volatile("s_waitcnt vmcnt(0)" ::: "memory");
        }
    }
    __syncthreads();
}

struct Args {
    const float* x; const float* c; const int* pos; const float* w_ada; const float* b_ada; const float* norm_g; const float* w_in;
    const float* conv_w; const float* conv_b; const float* gate_b; const float* ret_g; const float* q_g; const float* k_g; const float* sinks; const float* rel_bias;
    const float* w_up; const float* w_out; const float* w_ff1; const float* w_ff2; float* out; unsigned char* ws;
    int ph_lo, ph_hi, li, probe;
};
typedef const __attribute__((address_space(4))) Args* KArgs;
__device__ __forceinline__ KArgs kargs() { KArgs p = (KArgs)__builtin_amdgcn_kernarg_segment_ptr(); asm volatile("" : "+s"(p)); return p; }
constexpr int NWAVES = 8, NTHR = 512;
constexpr int RING_BYTES = 155648, LDSCTL_OFF = RING_BYTES, MISC_OFF = LDSCTL_OFF + 320, LDS_BYTES = 163840;

__device__ __forceinline__ void transpose64(const float* W, int ldw, int col0, int valid, bf16_t* WT, int wt_row0, int K, int k0, LAS float* scr, int lane, const float* sh, float* bias, bool dry = false) {
    const int n4 = (lane & 15) * 4, kr = lane >> 4;
    float4 v[16];
#pragma unroll
    for (int i = 0; i < 16; ++i) v[i] = (n4 < valid) ? *(const float4*)(W + (size_t)(k0 + 4 * i + kr) * ldw + col0 + n4) : make_float4(0.f, 0.f, 0.f, 0.f);
#pragma unroll
    for (int i = 0; i < 16; ++i) { LAS float* dp = scr + (4 * i + kr) * 68 + n4; *(LAS pg8::f32x4*)dp = (pg8::f32x4){v[i].x, v[i].y, v[i].z, v[i].w}; }
    asm volatile("s_waitcnt lgkmcnt(0)" ::: "memory");
    const int c = lane & 7;
#pragma unroll
    for (int j = 0; j < 8; ++j) { const int n = (lane >> 3) + 8 * j; const LAS float* sp = scr + (8 * c) * 68 + n;
        pg8::u32x4 o; o.x = pk2(sp[0 * 68], sp[1 * 68]); o.y = pk2(sp[2 * 68], sp[3 * 68]); o.z = pk2(sp[4 * 68], sp[5 * 68]); o.w = pk2(sp[6 * 68], sp[7 * 68]);
        if (!dry) *(pg8::u32x4*)(WT + (size_t)(wt_row0 + n) * K + k0 + 8 * c) = o; else asm volatile("" :: "v"(o)); }
    if (sh) { float a0 = 0.f, a1 = 0.f;
#pragma unroll 16
        for (int kk = 0; kk < 64; ++kk) { const float w = scr[kk * 68 + lane]; a0 += w * sh[k0 + kk]; a1 += w * sh[6144 + k0 + kk]; }
        if (dry) asm volatile("" :: "v"(a0), "v"(a1)); else if (lane < valid) { atomicAdd(bias + wt_row0 + lane, a0); atomicAdd(bias + BSTR + wt_row0 + lane, a1); } }
    asm volatile("s_waitcnt lgkmcnt(0)" ::: "memory");
}
__device__ __forceinline__ void convert_weights(const float* w_in, const float* w_up, const float* w_out, const float* w_ff1, const float* w_ff2, unsigned char* ws, int l, LAS unsigned char* lds, int gw, int NGW, int wave, int lane, bool dry = false) {
    LAS float* scr = (LAS float*)(lds + wave * 17408);
    bf16_t* WinT = (bf16_t*)(ws + WS_WIN); bf16_t* WupT = (bf16_t*)(ws + WS_WUP); bf16_t* WoutT = (bf16_t*)(ws + WS_WOUT); bf16_t* W1T = (bf16_t*)(ws + WS_W1); bf16_t* W2T = (bf16_t*)(ws + WS_W2);
    const float* sh1 = (const float*)(ws + WS_MOD) + (size_t)l * B_ * 2 * 3072;
    float* bias = (float*)(ws + WS_BIAS) + (size_t)l * B_ * BSTR;
    constexpr int I_IN = 16 * (NIN / 64), I_IF = 16, I_Z = 384, I_UP = 4 * 4 * 16, I_OUT = 16 * 16, I_1 = 16 * 64, I_2 = 64 * 16;
    constexpr int NITEMS = I_IN + I_IF + I_Z + I_UP + I_OUT + I_1 + I_2;
    for (int it = gw; it < NITEMS; it += NGW) {
        int r = it;
        if (r < I_IN) { const int nblk = NIN / 64, kb = r / nblk, nb = r % nblk; transpose64(w_in + (size_t)l * D_ * DIN, DIN, 64 * nb + ((nb * 64 >= 768) ? 8 : 0), 64, WinT, 64 * nb, D_, 64 * kb, scr, lane, sh1, bias, dry); continue; } r -= I_IN;
        if (r < I_IF) { transpose64(w_in + (size_t)l * D_ * DIN, DIN, 768, 8, WinT, NIN, D_, 64 * r, scr, lane, sh1, bias, dry); continue; } r -= I_IF;
        if (r < I_Z) { if (dry) continue; unsigned z = 0u; asm volatile("" : "+v"(z)); *(pg8::u32x4*)(WinT + (size_t)(NIN + 64) * D_ + (size_t)r * 512 + lane * 8) = (pg8::u32x4){z, z, z, z}; continue; } r -= I_Z;
        if (r < I_UP) { const int z = r / 64, rr = r % 64, kb = rr / 16, nb = rr % 16; transpose64(w_up + ((size_t)l * 4 + z) * 256 * 1024, 1024, 64 * nb, 64, WupT, z * 1024 + 64 * nb, 256, 64 * kb, scr, lane, nullptr, nullptr, dry); continue; } r -= I_UP;
        if (r < I_OUT) { transpose64(w_out + (size_t)l * D_ * D_, D_, 64 * (r % 16), 64, WoutT, 64 * (r % 16), D_, 64 * (r / 16), scr, lane, nullptr, nullptr, dry); continue; } r -= I_OUT;
        if (r < I_1) { transpose64(w_ff1 + (size_t)l * D_ * DFF, DFF, 64 * (r % 64), 64, W1T, 64 * (r % 64), D_, 64 * (r / 64), scr, lane, sh1 + 3072, bias + NINP, dry); continue; } r -= I_1;
        transpose64(w_ff2 + (size_t)l * DFF * D_, D_, 64 * (r % 16), 64, W2T, 64 * (r % 16), DFF, 64 * (r / 16), scr, lane, nullptr, nullptr, dry);
    }
}
__device__ __forceinline__ void gs_phase(const float* norm_g, const float* MOD, float* GS, int gtid, int NT) {
    for (int i = gtid; i < L_ * 2 * B_ * 1024; i += NT) { const int d = i & 1023, b = (i >> 10) & 1, j = (i >> 11) & 1, l = i >> 12;
        GS[i] = norm_g[(size_t)(l * 2 + j) * D_ + d] * (1.0f + MOD[(((size_t)l * 2 + b) * 2 + j) * 3072 + 1024 + d]); }
}
__device__ __forceinline__ void xprep_phase(const float* x, const float* g, const float* mod0  , bf16_t* H, float* ssq, int gw, int NGW, int lane, bool dry = false) {
    for (int m = gw; m < T_; m += NGW) {
        const int b = m / S_; const float* xr = x + (size_t)m * D_; const float* scale = mod0 + (size_t)b * 6144 + 1024;
        float ss = 0.f;
#pragma unroll
        for (int i = 0; i < 4; ++i) { const float4 t = *(const float4*)(xr + i * 256 + lane * 4); const float4 g4 = *(const float4*)(g + i * 256 + lane * 4), sc4 = *(const float4*)(scale + i * 256 + lane * 4);
            ss += t.x * t.x + t.y * t.y + t.z * t.z + t.w * t.w;
            uint2 o; o.x = pk2(t.x * g4.x * (1.0f + sc4.x), t.y * g4.y * (1.0f + sc4.y)); o.y = pk2(t.z * g4.z * (1.0f + sc4.z), t.w * g4.w * (1.0f + sc4.w));
            if (!dry) *(uint2*)(H + (size_t)m * D_ + i * 256 + lane * 4) = o; else asm volatile("" :: "v"(o.x), "v"(o.y)); }
        ss = wave_sum(ss);
        if (lane == 0 && !dry) ssq[m] = ss;
    }
}
__device__ __forceinline__ void mod_phase(const float* c, const float* w_ada, float* MODP, LAS unsigned char* lds, int bid, int G, int tid) {
    LAS float* cact = (LAS float*)lds;
    LAS float* red = cact + 2048;
    __syncthreads();
    for (int i = tid; i < 2048; i += NTHR) cact[i] = siluf_(c[i]);
    __syncthreads();
    for (int it = bid; it < L_ * 2 * 12 * 8; it += G) {
        const int dblk = it & 7, cblk = (it >> 3) % 12, lj = it / 96, e0 = cblk * 256, c4 = tid & 63, ds = tid >> 6, d0 = dblk * 128 + ds * 16;
        const float* w = w_ada + ((size_t)lj * 1024 + d0) * 3072 + e0 + 4 * c4;
        float4 wv[16];
#pragma unroll
        for (int i = 0; i < 16; ++i) wv[i] = *(const float4*)(w + (size_t)i * 3072);
        float a0[4] = {0.f, 0.f, 0.f, 0.f}, a1[4] = {0.f, 0.f, 0.f, 0.f};
#pragma unroll
        for (int i = 0; i < 16; ++i) { const float s0 = cact[d0 + i], s1 = cact[1024 + d0 + i];
            a0[0] += s0 * wv[i].x; a0[1] += s0 * wv[i].y; a0[2] += s0 * wv[i].z; a0[3] += s0 * wv[i].w; a1[0] += s1 * wv[i].x; a1[1] += s1 * wv[i].y; a1[2] += s1 * wv[i].z; a1[3] += s1 * wv[i].w; }
        LAS float* rp = red + (ds * 64 + c4) * 8;
#pragma unroll
        for (int k = 0; k < 4; ++k) { rp[k] = a0[k]; rp[4 + k] = a1[k]; }
        __syncthreads();
        { const int v = tid & 7, cc = tid >> 3, b = v >> 2, k = v & 3; float t = 0.f;
#pragma unroll
          for (int q = 0; q < 8; ++q) t += red[(q * 64 + cc) * 8 + v];
          const int l = lj >> 1, j = lj & 1, e = e0 + 4 * cc + k;
          MODP[(size_t)dblk * (L_ * B_ * 2 * 3072) + (((size_t)l * 2 + b) * 2 + j) * 3072 + e] = t; }
        __syncthreads();
    }
}
__device__ __forceinline__ void mod_reduce(const float* MODP, const float* b_ada, float* MOD, int gtid, int NT) {
    for (int i = gtid; i < L_ * B_ * 2 * 3072; i += NT) { const int e = i % 3072, j = (i / 3072) & 1, l = i / 12288; float t = b_ada[(size_t)(l * 2 + j) * 3072 + e];
#pragma unroll
        for (int q = 0; q < 8; ++q) t += MODP[(size_t)q * (L_ * B_ * 2 * 3072) + i];
        MOD[i] = t; }
}
namespace sbk {
typedef short bf16x8 __attribute__((ext_vector_type(8)));
typedef short s16x4 __attribute__((ext_vector_type(4)));
typedef float f32x16 __attribute__((ext_vector_type(16)));
typedef unsigned u32x4 __attribute__((ext_vector_type(4)));
typedef unsigned u32x2 __attribute__((ext_vector_type(2)));
constexpr int ROWB = 144, TILEB = 9728;
__device__ __forceinline__ int rowoff(int key) { return key * ROWB + (key >> 5) * 16; }
__device__ __forceinline__ s16x4 vtr(const LAS unsigned char* p) { typedef short v4i16_t __attribute__((ext_vector_type(4))); return __builtin_bit_cast(s16x4, __builtin_amdgcn_ds_read_tr16_b64_v4i16((LAS v4i16_t*)p)); }
__device__ __forceinline__ unsigned cvtpk(float lo, float hi) { return cvt_pk_visible(lo, hi); }

__device__ __forceinline__ void sb_unit(bf16_t* PM, int bh, int qb, LAS unsigned char* lds, bool dry) {
    int tid = threadIdx.x; asm volatile("" : "+v"(tid));
    const int lane = tid & 63, wave = __builtin_amdgcn_readfirstlane(tid >> 6), r = lane & 31, h = lane >> 5;
    const int b = bh >> 2, hh = bh & 3; const size_t mb = (size_t)b * S_;
    const int q0 = 256 * qb + 32 * wave;
    constexpr float C2 = 0.125f * 1.4426950408889634f;
    bf16x8 qf[4];
#pragma unroll
    for (int kk = 0; kk < 4; ++kk) { const u32x4 v = *(const u32x4*)(PM + (mb + q0 + r) * NPM + C_SQ + hh * 64 + 16 * kk + 8 * h); u32x4 w;
#pragma unroll
        for (int j = 0; j < 4; ++j) w[j] = cvtpk(__uint_as_float(v[j] << 16) * C2, __uint_as_float(v[j] & 0xffff0000u) * C2);
        qf[kk] = __builtin_bit_cast(bf16x8, w); }
    const int NT = 4 * qb + 4;
    const int srow = tid >> 3, sch = tid & 7;
    const bf16_t* sbase = PM + (mb + srow) * NPM + C_SK + hh * 64 + 8 * sch; const int swoff = rowoff(srow) + sch * 16;
    u32x4 sk, sv;
#define SB_LOAD(tl) do { const bf16_t* p_ = sbase + (size_t)(64 * (tl)) * NPM; sk = *(const u32x4*)p_; sv = *(const u32x4*)(p_ + (C_SV - C_SK)); } while (0)
#define SB_STORE(bs) do { *(LAS u32x4*)(lds + (bs) * 2 * TILEB + swoff) = sk; *(LAS u32x4*)(lds + (bs) * 2 * TILEB + TILEB + swoff) = sv; } while (0)
    const int kbase = rowoff(32 * ((r >> 2) & 1) + 4 * (r >> 3) + (r & 3)) + 16 * h;
    const int li = lane & 15;
    const int vbase = rowoff(32 * h + (li >> 2)) + (16 * ((lane >> 4) & 1) + 4 * (li & 3)) * 2;
    f32x16 o[2]; o[0] = (f32x16){}; o[1] = (f32x16){};
    float carry = 1.0f;
    volatile LAS unsigned* flg = (volatile LAS unsigned*)(lds + 4 * TILEB);
    __syncthreads();
    if (tid < 3) flg[tid] = 0u;
    SB_LOAD(NT - 1); SB_STORE(0);
    if (NT > 1) SB_LOAD(NT - 2);
    __syncthreads();
    for (int it = 0; it < NT; ++it) {
        const int tl = NT - 1 - it, bs = it & 1;
        if (it + 1 < NT) SB_STORE(bs ^ 1);
        if (it + 2 < NT) SB_LOAD(tl - 2);
        if (64 * tl <= q0 + 31) {
            const LAS unsigned char* Kb = lds + bs * 2 * TILEB; const LAS unsigned char* Vb = Kb + TILEB;
            f32x16 p0 = (f32x16){}, p1 = (f32x16){};
#pragma unroll
            for (int kk = 0; kk < 4; ++kk) {
                const bf16x8 a0 = *(const LAS bf16x8*)(Kb + kbase + kk * 32), a1 = *(const LAS bf16x8*)(Kb + kbase + 16 * ROWB + kk * 32);
                p0 = __builtin_amdgcn_mfma_f32_32x32x16_bf16(a0, qf[kk], p0, 0, 0, 0);
                p1 = __builtin_amdgcn_mfma_f32_32x32x16_bf16(a1, qf[kk], p1, 0, 0, 0);
            }
            if (64 * tl + 63 >= q0) {
                const int kq = 64 * tl + 32 * h - (q0 + r);
#pragma unroll
                for (int i = 0; i < 16; ++i) { if (kq + i >= 0) p0[i] = -INFINITY; if (kq + 16 + i >= 0) p1[i] = -INFINITY; }
            }
            float c = 1.0f;
#pragma unroll
            for (int i = 15; i >= 0; --i) { const float e = __builtin_amdgcn_exp2f(p1[i]); const float kp = __builtin_amdgcn_rcpf(1.0f + e); const float cn = c * kp; p1[i] = c - cn; c = cn; }
#pragma unroll
            for (int i = 15; i >= 0; --i) { const float e = __builtin_amdgcn_exp2f(p0[i]); const float kp = __builtin_amdgcn_rcpf(1.0f + e); const float cn = c * kp; p0[i] = c - cn; c = cn; }
            const auto rr = __builtin_amdgcn_permlane32_swap(__float_as_uint(c), __float_as_uint(c), false, false);
            const float c0 = h ? carry : carry * __uint_as_float(rr[1]);
            carry = carry * (__uint_as_float(rr[0]) * __uint_as_float(rr[1]));
            u32x4 bq[2][2];
#pragma unroll
            for (int s2 = 0; s2 < 2; ++s2)
#pragma unroll
                for (int j = 0; j < 4; ++j) { bq[0][s2][j] = cvtpk(p0[8 * s2 + 2 * j] * c0, p0[8 * s2 + 2 * j + 1] * c0); bq[1][s2][j] = cvtpk(p1[8 * s2 + 2 * j] * c0, p1[8 * s2 + 2 * j + 1] * c0); }
#pragma unroll
            for (int db = 0; db < 2; ++db)
#pragma unroll
                for (int p = 0; p < 2; ++p)
#pragma unroll
                    for (int s2 = 0; s2 < 2; ++s2) {
                        const s16x4 lo = vtr(Vb + vbase + (16 * p + 8 * s2) * ROWB + 64 * db), hi = vtr(Vb + vbase + (16 * p + 8 * s2 + 4) * ROWB + 64 * db);
                        const bf16x8 av = (bf16x8){lo[0], lo[1], lo[2], lo[3], hi[0], hi[1], hi[2], hi[3]};
                        o[db] = __builtin_amdgcn_mfma_f32_32x32x16_bf16(av, __builtin_bit_cast(bf16x8, bq[p][s2]), o[db], 0, 0, 0);
                    }
        }
        if (__any(carry != 0.0f) && lane == 0) flg[it % 3] = 1u;
        __syncthreads();
        const unsigned alive = flg[it % 3];
        if (tid == 0) flg[(it + 2) % 3] = 0u;
        if (!alive) break;
    }
#undef SB_LOAD
#undef SB_STORE
    if (!dry) {
        bf16_t* op = PM + (mb + q0 + r) * NPM + C_SQ + hh * 64 + 4 * h;
#pragma unroll
        for (int db = 0; db < 2; ++db)
#pragma unroll
            for (int g = 0; g < 4; ++g) { u32x2 w; w.x = cvtpk(o[db][4 * g], o[db][4 * g + 1]); w.y = cvtpk(o[db][4 * g + 2], o[db][4 * g + 3]); *(u32x2*)(op + 32 * db + 8 * g) = w; }
    }
}
__device__ __forceinline__ void sb_phase(bf16_t* PM, LAS unsigned char* lds, int bid, int G, bool dry) {
    for (int p = bid; p < 256; p += G) sb_unit(PM, p >> 5, p & 31, lds, dry);
    __syncthreads();
}
}

namespace cm {
typedef short bf16x8 __attribute__((ext_vector_type(8)));
typedef short s16x4 __attribute__((ext_vector_type(4)));
typedef float f32x16 __attribute__((ext_vector_type(16)));
typedef unsigned u32x4 __attribute__((ext_vector_type(4)));
typedef unsigned u32x2 __attribute__((ext_vector_type(2)));
constexpr int ROWB = 144, TB128 = 128 * ROWB + 16, TB64 = 64 * ROWB + 16;
__device__ __forceinline__ int rowoff(int row) { return row * ROWB + ((row >> 4) & 1) * 16; }
__device__ __forceinline__ s16x4 vtr(const LAS unsigned char* p) { typedef short v4i16_t __attribute__((ext_vector_type(4))); return __builtin_bit_cast(s16x4, __builtin_amdgcn_ds_read_tr16_b64_v4i16((LAS v4i16_t*)p)); }
__device__ __forceinline__ bf16x8 tr2(const LAS unsigned char* p) { const s16x4 lo = vtr(p), hi = vtr(p + 4 * ROWB); return (bf16x8){lo[0], lo[1], lo[2], lo[3], hi[0], hi[1], hi[2], hi[3]}; }
__device__ __forceinline__ unsigned cvtpk(float lo, float hi) { return cvt_pk_visible(lo, hi); }
__device__ __forceinline__ float lo16(unsigned v) { return __uint_as_float(v << 16); }
__device__ __forceinline__ float hi16(unsigned v) { return __uint_as_float(v & 0xffff0000u); }
__constant__ double INVF[32] = {1.0, 0.7498942093324559, 0.5623413251903491, 0.4216965034285822, 0.31622776601683794, 0.23713737056616552, 0.1778279410038923, 0.1333521432163324, 0.1, 0.07498942093324558, 0.05623413251903491, 0.042169650342858224, 0.03162277660168379, 0.023713737056616554, 0.01778279410038923, 0.01333521432163324, 0.01, 0.007498942093324558, 0.005623413251903491, 0.004216965034285823, 0.0031622776601683794, 0.0023713737056616554, 0.0017782794100389228, 0.001333521432163324, 0.001, 0.0007498942093324559, 0.0005623413251903491, 0.00042169650342858224, 0.00031622776601683794, 0.00023713737056616554, 0.00017782794100389227, 0.0001333521432163324};
__device__ __forceinline__ float ret_lg2(int h) { return log2f(1.0f - exp2f(-(5.0f + (float)h))); }

struct Lanes { int lane, wave, sub, wq, r, h, kfrag, tr16, tr8; };
__device__ __forceinline__ Lanes lanes() {
    Lanes L; int tid = threadIdx.x; asm volatile("" : "+v"(tid));
    L.lane = tid & 63; L.wave = __builtin_amdgcn_readfirstlane(tid >> 6); L.sub = L.wave >> 2; L.wq = L.wave & 3; L.r = L.lane & 31; L.h = L.lane >> 5;
    const int li = L.lane & 15, cb = 2 * (16 * ((L.lane >> 4) & 1) + 4 * (li & 3));
    L.kfrag = rowoff(16 * ((L.r >> 2) & 1) + 4 * (L.r >> 3) + (L.r & 3)) + 16 * L.h;
    L.tr16 = rowoff(16 * L.h + (li >> 2)) + cb;
    L.tr8 = rowoff(8 * L.h + (li >> 2)) + cb;
    return L;
}
#define CM_TR8(T, kk, col0) cm::tr2((T) + L.tr8 + (kk) * 16 * cm::ROWB + ((kk) & 1) * 16 + 2 * (col0))
#define CM_TR16(T, row0, s, col0) cm::tr2((T) + L.tr16 + ((row0) + 8 * (s)) * cm::ROWB + 2 * (col0))

__device__ __forceinline__ void stage_rot(const bf16_t* src, const float (&cs)[8], const float (&sn)[8], float scale, LAS unsigned char* T, int row, int c) {
    const u32x4 lo = *(const u32x4*)src, hi = *(const u32x4*)(src + 32); u32x4 olo, ohi;
#pragma unroll
    for (int j = 0; j < 4; ++j) { const float x1a = lo16(lo[j]), x1b = hi16(lo[j]), x2a = lo16(hi[j]), x2b = hi16(hi[j]);
        olo[j] = cvtpk((x1a * cs[2 * j] - x2a * sn[2 * j]) * scale, (x1b * cs[2 * j + 1] - x2b * sn[2 * j + 1]) * scale);
        ohi[j] = cvtpk((x1a * sn[2 * j] + x2a * cs[2 * j]) * scale, (x1b * sn[2 * j + 1] + x2b * cs[2 * j + 1]) * scale); }
    *(LAS u32x4*)(T + rowoff(row) + 16 * c) = olo; *(LAS u32x4*)(T + rowoff(row) + 16 * (c + 4)) = ohi;
}
__device__ __forceinline__ void rot_angles(const int* pos, size_t m, int c, float (&cs)[8], float (&sn)[8]) {
    const double p = (double)pos[m];
#pragma unroll
    for (int e = 0; e < 8; ++e) { double ang = p * INVF[8 * c + e]; ang -= 6.283185307179586 * rint(ang * 0.15915494309189535); sincosf((float)ang, &sn[e], &cs[e]); }
}
__device__ __forceinline__ void ret_local_unit(int u2, const bf16_t* PM, const int* pos, float* RL, LAS unsigned char* lds) {
    const Lanes L = lanes(); const int tid = L.wave * 64 + L.lane;
    const int b = u2 >> 7, hp = (u2 >> 6) & 1, n = u2 & 63; const size_t m0 = (size_t)b * S_ + 128 * n;
    __syncthreads();
    { const int row = tid >> 2, c = tid & 3; float cs[8], sn[8]; rot_angles(pos, m0 + row, c, cs, sn);
#pragma unroll
      for (int sub = 0; sub < 2; ++sub) { const int hd = 2 * hp + sub;
          stage_rot(PM + (m0 + row) * NPM + C_RK + hd * 64 + 8 * c, cs, sn, 0.125f * exp2f(-(float)row * ret_lg2(hd)), lds + sub * 2 * TB128, row, c); }
#pragma unroll
      for (int i = 0; i < 2; ++i) { const int it = tid + 512 * i, vr = it >> 3, ch = it & 7;
#pragma unroll
          for (int sub = 0; sub < 2; ++sub) *(LAS u32x4*)(lds + sub * 2 * TB128 + TB128 + rowoff(vr) + 16 * ch) = *(const u32x4*)(PM + (m0 + vr) * NPM + C_RV + (2 * hp + sub) * 64 + 8 * ch); } }
    __syncthreads();
    const LAS unsigned char* Kt = lds + L.sub * 2 * TB128; const LAS unsigned char* Vt = Kt + TB128;
    const int dkb = L.wq >> 1, dvb = L.wq & 1, hd = 2 * hp + L.sub;
    f32x16 acc = (f32x16){};
#pragma unroll
    for (int kk = 0; kk < 8; ++kk) acc = __builtin_amdgcn_mfma_f32_32x32x16_bf16(CM_TR8(Kt, kk, 32 * dkb), CM_TR8(Vt, kk, 32 * dvb), acc, 0, 0, 0);
    const float g127 = exp2f(127.0f * ret_lg2(hd));
    float* dst = RL + ((size_t)((b * 4 + hd) * NCH + n)) * 4096 + 32 * dvb + L.r;
#pragma unroll
    for (int i = 0; i < 16; ++i) dst[(32 * dkb + (i & 3) + 8 * (i >> 2) + 4 * L.h) * 64] = acc[i] * g127;
}
__device__ __forceinline__ void ret_out_unit(int u2, bf16_t* PM, const int* pos, const float* RL, const float* ret_g, LAS unsigned char* lds, bool dry) {
    const Lanes L = lanes(); const int tid = L.wave * 64 + L.lane;
    const int b = u2 >> 7, hp = (u2 >> 6) & 1, n = u2 & 63; const size_t m0 = (size_t)b * S_ + 128 * n;
    constexpr int SUBB = 3 * TB128 + TB64;
    __syncthreads();
    { const int row = tid >> 2, c = tid & 3; float cs[8], sn[8]; rot_angles(pos, m0 + row, c, cs, sn);
#pragma unroll
      for (int sub = 0; sub < 2; ++sub) { const int hd = 2 * hp + sub; const float lg = ret_lg2(hd);
          stage_rot(PM + (m0 + row) * NPM + C_RQ + hd * 64 + 8 * c, cs, sn, exp2f((float)row * lg), lds + sub * SUBB, row, c);
          stage_rot(PM + (m0 + row) * NPM + C_RK + hd * 64 + 8 * c, cs, sn, 0.125f * exp2f(-(float)row * lg), lds + sub * SUBB + TB128, row, c); }
#pragma unroll
      for (int i = 0; i < 2; ++i) { const int it = tid + 512 * i, vr = it >> 3, ch = it & 7;
#pragma unroll
          for (int sub = 0; sub < 2; ++sub) *(LAS u32x4*)(lds + sub * SUBB + 2 * TB128 + rowoff(vr) + 16 * ch) = *(const u32x4*)(PM + (m0 + vr) * NPM + C_RV + (2 * hp + sub) * 64 + 8 * ch); }
      { const int dk = tid >> 3, ch = tid & 7;
#pragma unroll
        for (int sub = 0; sub < 2; ++sub) { const int hd = 2 * hp + sub; const float g = exp2f(ret_lg2(hd));
            const float* sp = RL + ((size_t)((b * 4 + hd) * NCH + n)) * 4096 + dk * 64 + 8 * ch; const float4 s0 = *(const float4*)sp, s1 = *(const float4*)(sp + 4);
            u32x4 w; w[0] = cvtpk(s0.x * g, s0.y * g); w[1] = cvtpk(s0.z * g, s0.w * g); w[2] = cvtpk(s1.x * g, s1.y * g); w[3] = cvtpk(s1.z * g, s1.w * g);
            *(LAS u32x4*)(lds + sub * SUBB + 3 * TB128 + rowoff(dk) + 16 * ch) = w; } } }
    __syncthreads();
    const LAS unsigned char* Qt = lds + L.sub * SUBB; const LAS unsigned char* Kt = Qt + TB128; const LAS unsigned char* Vt = Kt + TB128; const LAS unsigned char* St = Vt + TB128;
    const int hd = 2 * hp + L.sub, wq = L.wq;
    bf16x8 qf[4];
#pragma unroll
    for (int kk = 0; kk < 4; ++kk) qf[kk] = *(const LAS bf16x8*)(Qt + rowoff(32 * wq + L.r) + 16 * L.h + 32 * kk);
    f32x16 o[2]; o[0] = (f32x16){}; o[1] = (f32x16){};
    for (int j = 0; j <= wq; ++j) {
        f32x16 p = (f32x16){};
#pragma unroll
        for (int kk = 0; kk < 4; ++kk) p = __builtin_amdgcn_mfma_f32_32x32x16_bf16(*(const LAS bf16x8*)(Kt + L.kfrag + 32 * j * ROWB + 32 * kk), qf[kk], p, 0, 0, 0);
        if (j == wq) {
#pragma unroll
            for (int i = 0; i < 16; ++i) if (16 * L.h + i > L.r) p[i] = 0.f;
        }
        u32x4 bq[2];
#pragma unroll
        for (int s = 0; s < 2; ++s)
#pragma unroll
            for (int t = 0; t < 4; ++t) bq[s][t] = cvtpk(p[8 * s + 2 * t], p[8 * s + 2 * t + 1]);
#pragma unroll
        for (int db = 0; db < 2; ++db)
#pragma unroll
            for (int s = 0; s < 2; ++s) o[db] = __builtin_amdgcn_mfma_f32_32x32x16_bf16(CM_TR16(Vt, 32 * j, s, 32 * db), __builtin_bit_cast(bf16x8, bq[s]), o[db], 0, 0, 0);
    }
#pragma unroll
    for (int db = 0; db < 2; ++db)
#pragma unroll
        for (int kk = 0; kk < 4; ++kk) o[db] = __builtin_amdgcn_mfma_f32_32x32x16_bf16(CM_TR8(St, kk, 32 * db), qf[kk], o[db], 0, 0, 0);
    float ss = 0.f;
#pragma unroll
    for (int db = 0; db < 2; ++db)
#pragma unroll
        for (int i = 0; i < 16; ++i) ss += o[db][i] * o[db][i];
    ss += __shfl_xor(ss, 32);
    const float rstd = 1.0f / sqrtf(ss * (1.0f / 64.0f) + 1e-6f);
    bf16_t* op = PM + (m0 + 32 * wq + L.r) * NPM + C_RG + hd * 64 + 4 * L.h; const float* gp = ret_g + hd * 64 + 4 * L.h;
#pragma unroll
    for (int db = 0; db < 2; ++db)
#pragma unroll
        for (int g = 0; g < 4; ++g) { const u32x2 gate = *(const u32x2*)(op + 32 * db + 8 * g); const float4 rg4 = *(const float4*)(gp + 32 * db + 8 * g);
            const float gv[4] = {lo16(gate.x), hi16(gate.x), lo16(gate.y), hi16(gate.y)}, rw[4] = {rg4.x, rg4.y, rg4.z, rg4.w}; float v[4];
#pragma unroll
            for (int t = 0; t < 4; ++t) v[t] = o[db][4 * g + t] * rstd * rw[t] * gv[t] / (1.0f + __expf(-gv[t]));
            u32x2 w; w.x = cvtpk(v[0], v[1]); w.y = cvtpk(v[2], v[3]); if (!dry) *(u32x2*)(op + 32 * db + 8 * g) = w; }
}
__device__ __forceinline__ void scan_phase(float* CL, float* RL, float* SM, int gtid, int NT) {
    for (int it = gtid; it < 32768 + 512 + 32768; it += NT) {
        if (it < 32768 + 512) {
            const bool isn = it >= 32768; const int bh = isn ? (it - 32768) >> 6 : it >> 12, e = isn ? (it - 32768) & 63 : it & 4095;
            float* base = isn ? SM + SM_NL + (size_t)bh * NCH * 64 + e : CL + (size_t)bh * NCH * 4096 + e; const int stride = isn ? 64 : 4096;
            float t[NCH];
#pragma unroll
            for (int n = 0; n < NCH; ++n) t[n] = base[(size_t)n * stride];
            float c = 0.f, m_st = 0.f;
#pragma unroll
            for (int n = 0; n < NCH; ++n) {
                const int u = bh * NCH + n;
                const float m_l = SM[SM_ML + u], a_l = SM[SM_AL + u];
                const float m_new = fmaxf(a_l + m_st, m_l), s_old = expf(a_l + m_st - m_new), s_new = expf(m_l - m_new);
                base[(size_t)n * stride] = c; c = s_old * c + s_new * t[n];
                if (!isn && e == 0) SM[SM_MI + u] = m_st;
                m_st = m_new;
            }
        } else {
            const int r = it - 32768 - 512, bh = r >> 12, e = r & 4095, h = bh & 3; const float dc = exp2f(128.0f * ret_lg2(h));
            float* base = RL + (size_t)bh * NCH * 4096 + e;
            float t[NCH];
#pragma unroll
            for (int n = 0; n < NCH; ++n) t[n] = base[(size_t)n * 4096];
            float c = 0.f;
#pragma unroll
            for (int n = 0; n < NCH; ++n) { base[(size_t)n * 4096] = c; c = dc * c + t[n]; }
        }
    }
}
}

namespace cm {
__device__ __forceinline__ float logsig(float x) { return fminf(x, 0.0f) - log1pf(__expf(-fabsf(x))); }
__device__ __forceinline__ float wave_scan_add(float v, int lane) {
#pragma unroll
    for (int o = 1; o < 64; o <<= 1) { const float t = __shfl_up(v, o); if (lane >= o) v += t; }
    return v;
}
__device__ __forceinline__ float wave_scan_max(float v, int lane) {
#pragma unroll
    for (int o = 1; o < 64; o <<= 1) { const float t = __shfl_up(v, o); if (lane >= o) v = fmaxf(v, t); }
    return v;
}
__device__ __forceinline__ float wave_max(float v) {
#pragma unroll
    for (int o = 1; o < 64; o <<= 1) v = fmaxf(v, __shfl_xor(v, o));
    return v;
}
__device__ __forceinline__ void stage_conv(const bf16_t* src, int trow, const float* cw, const float* cb, int chan, float mult, LAS unsigned char* T, int row, int ch) {
    float acc[8]; { const float4 b0 = *(const float4*)(cb + chan), b1 = *(const float4*)(cb + chan + 4); acc[0] = b0.x; acc[1] = b0.y; acc[2] = b0.z; acc[3] = b0.w; acc[4] = b1.x; acc[5] = b1.y; acc[6] = b1.z; acc[7] = b1.w; }
#pragma unroll
    for (int j = 0; j < 4; ++j) {
        if (trow - 3 + j >= 0) {
            const u32x4 x = *(const u32x4*)(src + (ptrdiff_t)(j - 3) * NPM); const float4 w0 = *(const float4*)(cw + j * 512 + chan), w1 = *(const float4*)(cw + j * 512 + chan + 4);
            acc[0] += w0.x * lo16(x[0]); acc[1] += w0.y * hi16(x[0]); acc[2] += w0.z * lo16(x[1]); acc[3] += w0.w * hi16(x[1]);
            acc[4] += w1.x * lo16(x[2]); acc[5] += w1.y * hi16(x[2]); acc[6] += w1.z * lo16(x[3]); acc[7] += w1.w * hi16(x[3]);
        }
    }
    u32x4 o;
#pragma unroll
    for (int j = 0; j < 4; ++j) { const float v0 = acc[2 * j], v1 = acc[2 * j + 1]; o[j] = cvtpk(v0 / (1.0f + __expf(-v0)) * mult, v1 / (1.0f + __expf(-v1)) * mult); }
    *(LAS u32x4*)(T + rowoff(row) + 16 * ch) = o;
}
__device__ __forceinline__ void ml_local_unit(int u2, const bf16_t* PM, const float* IF, const float* cw, const float* cb, float* CL, float* SM, LAS unsigned char* lds) {
    const Lanes L = lanes(); const int tid = L.wave * 64 + L.lane;
    const int b = u2 >> 7, hp = (u2 >> 6) & 1, n = u2 & 63; const size_t m0 = (size_t)b * S_ + 128 * n;
    const int t = tid & 255, ts = tid >> 8, thd = 2 * hp + ts;
    LAS float* sc = (LAS float*)(lds + 4 * TB128) + ts * 512;
    __syncthreads();
    float a_row = 0.f, g_row = -INFINITY, m_loc = 0.f, a_last = 0.f;
    if (t < 128) { a_row = wave_scan_add(logsig(IF[(m0 + t) * 8 + 4 + thd]), L.lane); if (t == 63) sc[0] = a_row; }
    __syncthreads();
    if (t < 128) { if (t >= 64) a_row += sc[0]; if (t == 127) sc[1] = a_row; }
    __syncthreads();
    if (t < 128) { a_last = sc[1]; g_row = a_last - a_row + IF[(m0 + t) * 8 + thd]; const float mw = wave_max(g_row); if ((t & 63) == 0) sc[2 + (t >> 6)] = mw; }
    __syncthreads();
    if (t < 128) { m_loc = fmaxf(sc[2], sc[3]); sc[256 + t] = __expf(g_row - m_loc); }
    __syncthreads();
#pragma unroll
    for (int i = 0; i < 2; ++i) { const int it = tid + 512 * i, row = it >> 3, ch = it & 7;
#pragma unroll
        for (int sub = 0; sub < 2; ++sub) { const int hd = 2 * hp + sub; const float w = ((LAS float*)(lds + 4 * TB128))[sub * 512 + 256 + row];
            stage_conv(PM + (m0 + row) * NPM + C_MK + hd * 64 + 8 * ch, 128 * n + row, cw, cb, 256 + hd * 64 + 8 * ch, w, lds + sub * 2 * TB128, row, ch);
            *(LAS u32x4*)(lds + sub * 2 * TB128 + TB128 + rowoff(row) + 16 * ch) = *(const u32x4*)(PM + (m0 + row) * NPM + C_MV + hd * 64 + 8 * ch); } }
    __syncthreads();
    const LAS unsigned char* Kt = lds + L.sub * 2 * TB128; const LAS unsigned char* Vt = Kt + TB128;
    const int dkb = L.wq >> 1, dvb = L.wq & 1, hd = 2 * hp + L.sub; const int u = (b * 4 + hd) * NCH + n;
    f32x16 acc = (f32x16){}, accn = (f32x16){};
    const bf16x8 ones = (bf16x8){0x3f80, 0x3f80, 0x3f80, 0x3f80, 0x3f80, 0x3f80, 0x3f80, 0x3f80};
#pragma unroll
    for (int kk = 0; kk < 8; ++kk) { const bf16x8 kf = CM_TR8(Kt, kk, 32 * dkb); acc = __builtin_amdgcn_mfma_f32_32x32x16_bf16(kf, CM_TR8(Vt, kk, 32 * dvb), acc, 0, 0, 0);
        if (dvb == 0) accn = __builtin_amdgcn_mfma_f32_32x32x16_bf16(kf, ones, accn, 0, 0, 0); }
    float* dst = CL + (size_t)u * 4096 + 32 * dvb + L.r;
#pragma unroll
    for (int i = 0; i < 16; ++i) dst[(32 * dkb + (i & 3) + 8 * (i >> 2) + 4 * L.h) * 64] = acc[i];
    if (dvb == 0 && L.r == 0) {
#pragma unroll
        for (int i = 0; i < 16; ++i) SM[SM_NL + u * 64 + 32 * dkb + (i & 3) + 8 * (i >> 2) + 4 * L.h] = accn[i]; }
    if (t == 0) { const int uu = (b * 4 + thd) * NCH + n; SM[SM_ML + uu] = m_loc; SM[SM_AL + uu] = a_last; }
}
__device__ __forceinline__ void ml_out_unit(int u2, bf16_t* PM, const float* IF, const float* cw, const float* cb, const float* CL, const float* SM, LAS unsigned char* lds, bool dry) {
    const Lanes L = lanes(); const int tid = L.wave * 64 + L.lane;
    const int b = u2 >> 7, hp = (u2 >> 6) & 1, n = u2 & 63; const size_t m0 = (size_t)b * S_ + 128 * n;
    constexpr int SUBB = 3 * TB128 + TB64, SCB = 2304;
    const int t = tid & 255, ts = tid >> 8, thd = 2 * hp + ts; const int tu = (b * 4 + thd) * NCH + n;
    LAS float* sc = (LAS float*)(lds + 2 * SUBB + ts * SCB);
    LAS float* tmp = (LAS float*)(lds + 2 * SUBB + 2 * SCB) + ts * 256;
    __syncthreads();
    if (t < 128) tmp[t] = logsig(IF[(m0 + t) * 8 + 4 + thd]);
#pragma unroll
    for (int i = 0; i < 2; ++i) { const int it = tid + 512 * i, row = it >> 3, ch = it & 7;
#pragma unroll
        for (int sub = 0; sub < 2; ++sub) { const int hd = 2 * hp + sub;
            stage_conv(PM + (m0 + row) * NPM + C_MQ + hd * 64 + 8 * ch, 128 * n + row, cw, cb, hd * 64 + 8 * ch, 0.125f, lds + sub * SUBB, row, ch);
            stage_conv(PM + (m0 + row) * NPM + C_MK + hd * 64 + 8 * ch, 128 * n + row, cw, cb, 256 + hd * 64 + 8 * ch, 1.0f, lds + sub * SUBB + TB128, row, ch);
            *(LAS u32x4*)(lds + sub * SUBB + 2 * TB128 + rowoff(row) + 16 * ch) = *(const u32x4*)(PM + (m0 + row) * NPM + C_MV + hd * 64 + 8 * ch); } }
    { const int dk = tid >> 3, ch = tid & 7;
#pragma unroll
      for (int sub = 0; sub < 2; ++sub) { const int hd = 2 * hp + sub;
          const float* sp = CL + ((size_t)((b * 4 + hd) * NCH + n)) * 4096 + dk * 64 + 8 * ch; const float4 s0 = *(const float4*)sp, s1 = *(const float4*)(sp + 4);
          u32x4 w; w[0] = cvtpk(s0.x, s0.y); w[1] = cvtpk(s0.z, s0.w); w[2] = cvtpk(s1.x, s1.y); w[3] = cvtpk(s1.z, s1.w);
          *(LAS u32x4*)(lds + sub * SUBB + 3 * TB128 + rowoff(dk) + 16 * ch) = w; } }
    if (t < 32) { const float2 nv = *(const float2*)(SM + SM_NL + tu * 64 + 2 * t); ((LAS unsigned*)(sc + 512))[t] = cvtpk(nv.x, nv.y); }
    __syncthreads();
    float a_row = 0.f, bb_row = -INFINITY, cm_row = -INFINITY;
    if (t < 128) { a_row = wave_scan_add(tmp[t], L.lane); if (t == 63) tmp[128] = a_row; }
    __syncthreads();
    if (t < 128) { if (t >= 64) a_row += tmp[128]; bb_row = IF[(m0 + t) * 8 + thd] - a_row; sc[t] = bb_row; cm_row = wave_scan_max(bb_row, L.lane); if (t == 63) tmp[129] = cm_row; }
    __syncthreads();
    if (t < 128) { if (t >= 64) cm_row = fmaxf(cm_row, tmp[129]); const float m_in = SM[SM_MI + tu];
        const float m_inter = a_row + m_in, m_tot = fmaxf(m_inter, a_row + cm_row); sc[128 + t] = a_row - m_tot; sc[256 + t] = __expf(m_inter - m_tot); sc[384 + t] = __expf(-m_tot); }
    __syncthreads();
    const LAS unsigned char* Qt = lds + L.sub * SUBB; const LAS unsigned char* Kt = Qt + TB128; const LAS unsigned char* Vt = Kt + TB128; const LAS unsigned char* Ct = Vt + TB128;
    const LAS float* scw = (const LAS float*)(lds + 2 * SUBB + L.sub * SCB);
    const int hd = 2 * hp + L.sub, wq = L.wq, ql = 32 * wq + L.r;
    const float rowA = scw[128 + ql], sint = scw[256 + ql], emt = scw[384 + ql];
    bf16x8 qf[4];
#pragma unroll
    for (int kk = 0; kk < 4; ++kk) qf[kk] = *(const LAS bf16x8*)(Qt + rowoff(ql) + 16 * L.h + 32 * kk);
    f32x16 o[2]; o[0] = (f32x16){}; o[1] = (f32x16){}; f32x16 o3 = (f32x16){};
#pragma unroll
    for (int kk = 0; kk < 4; ++kk) {
#pragma unroll
        for (int db = 0; db < 2; ++db) o[db] = __builtin_amdgcn_mfma_f32_32x32x16_bf16(CM_TR8(Ct, kk, 32 * db), qf[kk], o[db], 0, 0, 0);
        bf16x8 nf = (bf16x8){}; if (L.r == 0) nf = *(const LAS bf16x8*)((const LAS unsigned char*)(scw + 512) + 2 * (16 * kk + 8 * L.h));
        o3 = __builtin_amdgcn_mfma_f32_32x32x16_bf16(nf, qf[kk], o3, 0, 0, 0);
    }
    const float qn = __shfl(o3[0], L.r);
#pragma unroll
    for (int db = 0; db < 2; ++db)
#pragma unroll
        for (int i = 0; i < 16; ++i) o[db][i] *= sint;
    float psum = 0.f;
    for (int j = 0; j <= wq; ++j) {
        f32x16 p = (f32x16){};
#pragma unroll
        for (int kk = 0; kk < 4; ++kk) p = __builtin_amdgcn_mfma_f32_32x32x16_bf16(*(const LAS bf16x8*)(Kt + L.kfrag + 32 * j * ROWB + 32 * kk), qf[kk], p, 0, 0, 0);
        const LAS float* bbp = scw + 32 * j + 16 * L.h;
#pragma unroll
        for (int i = 0; i < 16; ++i) { float w = __expf(rowA + bbp[i]) * p[i]; if (j == wq && 16 * L.h + i > L.r) w = 0.f; p[i] = w; psum += w; }
        u32x4 bq[2];
#pragma unroll
        for (int s = 0; s < 2; ++s)
#pragma unroll
            for (int tt = 0; tt < 4; ++tt) bq[s][tt] = cvtpk(p[8 * s + 2 * tt], p[8 * s + 2 * tt + 1]);
#pragma unroll
        for (int db = 0; db < 2; ++db)
#pragma unroll
            for (int s = 0; s < 2; ++s) o[db] = __builtin_amdgcn_mfma_f32_32x32x16_bf16(CM_TR16(Vt, 32 * j, s, 32 * db), __builtin_bit_cast(bf16x8, bq[s]), o[db], 0, 0, 0);
    }
    psum += __shfl_xor(psum, 32);
    const float den = sint * qn + psum, dn = 1.0f / fmaxf(fabsf(den), emt);
    bf16_t* op = PM + (m0 + ql) * NPM + C_MO + hd * 64 + 4 * L.h;
#pragma unroll
    for (int db = 0; db < 2; ++db)
#pragma unroll
        for (int g = 0; g < 4; ++g) { const u32x2 gate = *(const u32x2*)(op + 32 * db + 8 * g);
            const float gv[4] = {lo16(gate.x), hi16(gate.x), lo16(gate.y), hi16(gate.y)}; float v[4];
#pragma unroll
            for (int tt = 0; tt < 4; ++tt) v[tt] = o[db][4 * g + tt] * dn / (1.0f + __expf(-gv[tt]));
            u32x2 w; w.x = cvtpk(v[0], v[1]); w.y = cvtpk(v[2], v[3]); if (!dry) *(u32x2*)(op + 32 * db + 8 * g) = w; }
}
}

namespace cm {
constexpr int TB256 = 256 * ROWB + 16;
__device__ __forceinline__ int t5_bucket(int rel) {
    const int n = rel > 0 ? rel : 0;
    if (n < 16) return n;
    const int large = 16 + (int)(logf((float)n / 16.0f) / 2.0794415416798357f * 16.0f);
    return large < 31 ? large : 31;
}
__device__ __forceinline__ void stage_norm(const bf16_t* src, bool live, const float* gain8, float mult, LAS unsigned char* dst) {
    u32x4 x = (u32x4){0u, 0u, 0u, 0u}; if (live) x = *(const u32x4*)src;
    float v[8]; float ss = 0.f;
#pragma unroll
    for (int j = 0; j < 4; ++j) { v[2 * j] = lo16(x[j]); v[2 * j + 1] = hi16(x[j]); ss += v[2 * j] * v[2 * j] + v[2 * j + 1] * v[2 * j + 1]; }
    ss += __shfl_xor(ss, 1); ss += __shfl_xor(ss, 2); ss += __shfl_xor(ss, 4);
    const float rs = mult / sqrtf(ss * (1.0f / 64.0f) + 1e-6f);
    const float4 g0 = *(const float4*)gain8, g1 = *(const float4*)(gain8 + 4);
    u32x4 o; o[0] = cvtpk(v[0] * rs * g0.x, v[1] * rs * g0.y); o[1] = cvtpk(v[2] * rs * g0.z, v[3] * rs * g0.w); o[2] = cvtpk(v[4] * rs * g1.x, v[5] * rs * g1.y); o[3] = cvtpk(v[6] * rs * g1.z, v[7] * rs * g1.w);
    *(LAS u32x4*)dst = o;
}
__device__ __forceinline__ void swa_unit(int u2, bf16_t* PM, const int* pos, const float* q_g, const float* k_g, const float* sinks, const float* rel_bias, LAS unsigned char* lds, bool dry) {
    const Lanes L = lanes(); const int tid = L.wave * 64 + L.lane;
    const int b = u2 >> 7, g = (u2 >> 6) & 1, nb = u2 & 63; const size_t mb = (size_t)b * S_; const int s0 = 128 * nb - 128;
    LAS unsigned char* Kt = lds; LAS unsigned char* Vt = lds + TB256; LAS unsigned char* Qt0 = lds + 2 * TB256;
    LAS int* posk = (LAS int*)(lds + 2 * TB256 + 2 * TB128); LAS float* tb = (LAS float*)(posk + 256);
    __syncthreads();
#pragma unroll
    for (int i = 0; i < 4; ++i) { const int it = tid + 512 * i, row = it >> 3, ch = it & 7; const int s = s0 + row; const bool live = s >= 0;
        const bf16_t* kp = PM + (mb + (live ? s : 0)) * NPM + C_AK + g * 64 + 8 * ch;
        stage_norm(kp, live, k_g + 8 * ch, 1.0f, Kt + rowoff(row) + 16 * ch);
        u32x4 vv = (u32x4){0u, 0u, 0u, 0u}; if (live) vv = *(const u32x4*)(kp + (C_AV - C_AK));
        *(LAS u32x4*)(Vt + rowoff(row) + 16 * ch) = vv; }
#pragma unroll
    for (int i = 0; i < 2; ++i) { const int it = tid + 512 * i, row = it >> 3, ch = it & 7;
#pragma unroll
        for (int sub = 0; sub < 2; ++sub) stage_norm(PM + (mb + 128 * nb + row) * NPM + C_AQ + (2 * g + sub) * 64 + 8 * ch, true, q_g + 8 * ch, 0.125f, Qt0 + sub * TB128 + rowoff(row) + 16 * ch); }
    if (tid < 256) { const int s = s0 + tid; posk[tid] = pos[mb + (s >= 0 ? s : 0)]; }
    { const int sub = tid >> 8, nn = tid & 255; tb[sub * 256 + nn] = rel_bias[t5_bucket(nn) * 4 + 2 * g + sub]; }
    __syncthreads();
    const int hq = 2 * g + L.sub, wq = L.wq, ql = 32 * wq + L.r, jq = 128 + ql;
    const LAS unsigned char* Qt = Qt0 + L.sub * TB128; const LAS float* tbh = tb + L.sub * 256;
    bf16x8 qf[4];
#pragma unroll
    for (int kk = 0; kk < 4; ++kk) qf[kk] = *(const LAS bf16x8*)(Qt + rowoff(ql) + 16 * L.h + 32 * kk);
    const int pq = posk[jq]; const float sink = sinks[hq];
    f32x16 p[5]; float mx = sink;
#pragma unroll
    for (int jj = 0; jj < 5; ++jj) {
        const int T = wq + jj; f32x16 acc = (f32x16){};
#pragma unroll
        for (int kk = 0; kk < 4; ++kk) acc = __builtin_amdgcn_mfma_f32_32x32x16_bf16(*(const LAS bf16x8*)(Kt + L.kfrag + 32 * T * ROWB + 32 * kk), qf[kk], acc, 0, 0, 0);
        const int jb0 = 32 * T + 16 * L.h;
#pragma unroll
        for (int i = 0; i < 16; ++i) { const int jb = jb0 + i, dist = jq - jb; int idx = pq - posk[jb]; idx = idx < 0 ? 0 : (idx > 255 ? 255 : idx);
            float z = acc[i] + tbh[idx]; if (!(dist >= 0 && dist < 128 && s0 + jb >= 0)) z = -INFINITY; acc[i] = z; mx = fmaxf(mx, z); }
        p[jj] = acc;
    }
    mx = fmaxf(mx, __shfl_xor(mx, 32));
    float den = 0.f;
#pragma unroll
    for (int jj = 0; jj < 5; ++jj)
#pragma unroll
        for (int i = 0; i < 16; ++i) { const float e = __expf(p[jj][i] - mx); p[jj][i] = e; den += e; }
    den += __shfl_xor(den, 32); den += __expf(sink - mx);
    f32x16 o[2]; o[0] = (f32x16){}; o[1] = (f32x16){};
#pragma unroll
    for (int jj = 0; jj < 5; ++jj) {
        const int T = wq + jj; u32x4 bq[2];
#pragma unroll
        for (int s = 0; s < 2; ++s)
#pragma unroll
            for (int tt = 0; tt < 4; ++tt) bq[s][tt] = cvtpk(p[jj][8 * s + 2 * tt], p[jj][8 * s + 2 * tt + 1]);
#pragma unroll
        for (int db = 0; db < 2; ++db)
#pragma unroll
            for (int s = 0; s < 2; ++s) o[db] = __builtin_amdgcn_mfma_f32_32x32x16_bf16(CM_TR16(Vt, 32 * T, s, 32 * db), __builtin_bit_cast(bf16x8, bq[s]), o[db], 0, 0, 0);
    }
    const float dn = 1.0f / den;
    bf16_t* op = PM + (mb + 128 * nb + ql) * NPM + C_AQ + hq * 64 + 4 * L.h;
#pragma unroll
    for (int db = 0; db < 2; ++db)
#pragma unroll
        for (int g4 = 0; g4 < 4; ++g4) { u32x2 w; w.x = cvtpk(o[db][4 * g4] * dn, o[db][4 * g4 + 1] * dn); w.y = cvtpk(o[db][4 * g4 + 2] * dn, o[db][4 * g4 + 3] * dn); if (!dry) *(u32x2*)(op + 32 * db + 8 * g4) = w; }
}
}

constexpr int N_PHASES = 2 + 9 * L_;
__global__ void __launch_bounds__(NTHR, 2) mega_fwd(Args a_unused) {
    extern __shared__ __attribute__((aligned(16))) unsigned char lds_raw[];
    LAS unsigned char* lds = (LAS unsigned char*)lds_raw;
    volatile LAS unsigned* MISC = (volatile LAS unsigned*)(lds + MISC_OFF);
    const int G0 = gridDim.x, bid0 = blockIdx.x;
#define PH_S() int bid = bid0, G = G0; asm volatile("" : "+s"(bid), "+s"(G));
#define PHASE_IDS() int tid = threadIdx.x; asm volatile("" : "+v"(tid)); const int lane = tid & 63, wave = __builtin_amdgcn_readfirstlane(tid >> 6); \
    const int gw = bid * NWAVES + wave, NGW = G * NWAVES, gtid = bid * NTHR + tid, NT = G * NTHR; (void)lane; (void)gw; (void)NGW; (void)gtid; (void)NT;
    for (int u = threadIdx.x; u < (LDS_BYTES - LDSCTL_OFF) / 4; u += NTHR) ((LAS unsigned*)(lds + LDSCTL_OFF))[u] = 0u;
    __syncthreads();
    const int ph_lo = kargs()->ph_lo, ph_hi = kargs()->ph_hi;
    XcdBarrier bar = xcd_barrier_post((unsigned*)(kargs()->ws + WS_CTL) + CW_BAR + kargs()->li * XCD_BAR_WORDS, MISC + 8);
#define IN(k) (ph_lo <= (k) && (k) < ph_hi)
#define SEAM(k) do { if (IN(k) && IN((k) + 1)) xcd_barrier(bar); } while (0)
#define WSP(T, off) ((T*)(ka->ws + (off)))
    const unsigned probe = (unsigned)kargs()->probe;
#define REPS(kind) (((probe >> (kind)) & 1u) ? 2 : 1)
    if (IN(0)) { { PH_S(); PHASE_IDS(); KArgs ka = kargs(); mod_phase(ka->c, ka->w_ada, WSP(float, WS_ST_ML), lds, bid, G, tid); }
        xcd_barrier(bar);
        { PH_S(); PHASE_IDS(); KArgs ka = kargs(); mod_reduce(WSP(float, WS_ST_ML), ka->b_ada, WSP(float, WS_MOD), gtid, NT); } }
    SEAM(0);
    if (IN(1)) for (int rep = REPS(1) + ((probe >> 3) & 1u); rep > 0; --rep) { PH_S(); PHASE_IDS(); KArgs ka = kargs(); const bool dry = rep > 1;
        if (!((probe >> 4) & 1u) || !dry) convert_weights(ka->w_in, ka->w_up, ka->w_out, ka->w_ff1, ka->w_ff2, ka->ws, 0, lds, gw, NGW, wave, lane, dry);
        gs_phase(ka->norm_g, WSP(float, WS_MOD), WSP(float, WS_GS), gtid, NT);
        xprep_phase(ka->x, ka->norm_g, WSP(float, WS_MOD), WSP(bf16_t, WS_H), WSP(float, WS_SSQ), gw, NGW, lane, dry); __syncthreads(); }
    SEAM(1);

    for (int l = 0; l < L_; ++l) {
        const int pb = 2 + 9 * l;
        if (l > 0) { if (IN(pb + 0)) { PH_S(); PHASE_IDS(); KArgs ka = kargs(); convert_weights(ka->w_in, ka->w_up, ka->w_out, ka->w_ff1, ka->w_ff2, ka->ws, l, lds, gw, NGW, wave, lane); __syncthreads(); } SEAM(pb + 0); }
        if (IN(pb + 1)) for (int rep = REPS(2); rep > 0; --rep) { PH_S(); KArgs ka = kargs(); pg8::Gemm g{WSP(bf16_t, WS_H), WSP(bf16_t, WS_WIN)}; pg8::StaticOrder S; S.init(T_, NINP, G, bid);
            pg8::EpiIn E{ka->ws, ka->gate_b + l * 8, l}; pg8::gemm_phase<D_, D_>(lds, g, S, E); }
        SEAM(pb + 1);
        if (IN(pb + 2)) { PH_S(); KArgs ka = kargs();
            for (int rep = REPS(12); rep > 0; --rep) sbk::sb_phase(WSP(bf16_t, WS_PM), lds, bid, G, rep > 1);
            for (int rep = REPS(13); rep > 0; --rep) for (int u2 = bid; u2 < 256; u2 += G) cm::swa_unit(u2, WSP(bf16_t, WS_PM), ka->pos, ka->q_g + l * 64, ka->k_g + l * 64, ka->sinks + l * 4, ka->rel_bias, lds, rep > 1);
            for (int rep = REPS(14); rep > 0; --rep) for (int u2 = bid; u2 < 256; u2 += G) cm::ret_local_unit(u2, WSP(bf16_t, WS_PM), ka->pos, WSP(float, WS_ST_RT), lds);
            for (int rep = REPS(15); rep > 0; --rep) for (int u2 = bid; u2 < 256; u2 += G) cm::ml_local_unit(u2, WSP(bf16_t, WS_PM), WSP(float, WS_IF), ka->conv_w + (size_t)l * 4 * 512, ka->conv_b + (size_t)l * 512, WSP(float, WS_ST_ML), WSP(float, WS_SMALL), lds);
            __syncthreads();
        }
        SEAM(pb + 2);
        if (IN(pb + 3)) { PH_S(); PHASE_IDS(); KArgs ka = kargs(); cm::scan_phase(WSP(float, WS_ST_ML), WSP(float, WS_ST_RT), WSP(float, WS_SMALL), gtid, NT); }
        SEAM(pb + 3);
        if (IN(pb + 4)) for (int rep = REPS(6); rep > 0; --rep) { PH_S(); KArgs ka = kargs(); const bool dry = rep > 1;
            for (int u2 = bid; u2 < 256; u2 += G) cm::ret_out_unit(u2, WSP(bf16_t, WS_PM), ka->pos, WSP(float, WS_ST_RT), ka->ret_g + (size_t)l * 256, lds, dry);
            for (int u2 = bid; u2 < 256; u2 += G) cm::ml_out_unit(u2, WSP(bf16_t, WS_PM), WSP(float, WS_IF), ka->conv_w + (size_t)l * 4 * 512, ka->conv_b + (size_t)l * 512, WSP(float, WS_ST_ML), WSP(float, WS_SMALL), lds, dry);
            __syncthreads();
        }
        SEAM(pb + 4);
        if (IN(pb + 5)) for (int rep = REPS(7); rep > 0; --rep) { PH_S(); KArgs ka = kargs(); pg8::Gemm g{WSP(bf16_t, WS_PM), WSP(bf16_t, WS_WUP)}; pg8::UpOrder S; S.so.init(T_, D_, G, bid);
          pg8::EpiUp E{WSP(bf16_t, WS_H), WSP(u8, WS_GT), rep > 1}; pg8::gemm_phase<NPM, 256, false>(lds, g, S, E); }
        SEAM(pb + 5);
        if (IN(pb + 6)) for (int rep = REPS(8); rep > 0; --rep) { PH_S(); KArgs ka = kargs(); pg8::Gemm g{WSP(bf16_t, WS_H), WSP(bf16_t, WS_WOUT)}; pg8::StaticOrder S; S.init(T_, D_, G, bid);
          pg8::EpiRes E{(l == 0) ? ka->x : ka->out, ka->out, WSP(float, WS_MOD) + (size_t)l * B_ * 2 * 3072 + 2048, WSP(float, WS_GS) + (size_t)(l * 2 + 1) * B_ * 1024, WSP(bf16_t, WS_H2), WSP(float, WS_SSQ) + (size_t)(l * 2 + 1) * T_, rep > 1};
          pg8::gemm_phase<D_, D_>(lds, g, S, E); }
        SEAM(pb + 6);
        if (IN(pb + 7)) for (int rep = REPS(10); rep > 0; --rep) { PH_S(); KArgs ka = kargs(); pg8::Gemm g{WSP(bf16_t, WS_H2), WSP(bf16_t, WS_W1)}; pg8::StaticOrder S; S.init(T_, DFF, G, bid);
          pg8::EpiFF1 E{WSP(bf16_t, WS_HID), WSP(float, WS_SSQ) + (size_t)(l * 2 + 1) * T_, WSP(float, WS_BIAS) + (size_t)l * B_ * BSTR + NINP}; pg8::gemm_phase<D_, D_>(lds, g, S, E); }
        SEAM(pb + 7);
        if (IN(pb + 8)) for (int rep = REPS(11); rep > 0; --rep) { PH_S(); KArgs ka = kargs(); pg8::Gemm g{WSP(bf16_t, WS_HID), WSP(bf16_t, WS_W2)}; pg8::StaticOrder S; S.init(T_, D_, G, bid); const bool nxt = l + 1 < L_;
          pg8::EpiRes E{ka->out, ka->out, WSP(float, WS_MOD) + (size_t)l * B_ * 2 * 3072 + 3072 + 2048, nxt ? WSP(float, WS_GS) + (size_t)((l + 1) * 2 + 0) * B_ * 1024 : nullptr, WSP(bf16_t, WS_H), WSP(float, WS_SSQ) + (size_t)((l + 1) * 2 + 0) * T_, rep > 1};
          pg8::gemm_phase<DFF, DFF>(lds, g, S, E); }
        SEAM(pb + 8);
    }
}

extern "C" void kernel_launch(void* const* d_in, const int* in_sizes, int n_in, void* d_out, int out_size, void* d_ws, size_t ws_size, hipStream_t stream) {
    static int grid = 0;
    if (grid == 0) {
        int dev = 0, cus = 0;
        if (hipGetDevice(&dev) != hipSuccess || hipDeviceGetAttribute(&cus, hipDeviceAttributeMultiprocessorCount, dev) != hipSuccess) { fprintf(stderr, "kernel_launch: device query failed\n"); grid = -1; return; }
        if (hipFuncSetAttribute((const void*)mega_fwd, hipFuncAttributeMaxDynamicSharedMemorySize, LDS_BYTES) != hipSuccess) { fprintf(stderr, "kernel_launch: hipFuncSetAttribute failed\n"); grid = -1; return; }
        int per_cu = 0;
        if (hipOccupancyMaxActiveBlocksPerMultiprocessor(&per_cu, (const void*)mega_fwd, NTHR, LDS_BYTES) != hipSuccess || per_cu < 1) fprintf(stderr, "kernel_launch: occupancy query reports %d\n", per_cu);
        (void)hipGetLastError();
        grid = cus;
    }
    if (grid < 0) return;
    (void)hipMemsetAsync((char*)d_ws + WS_CTL, 0, CTL_ZERO_BYTES, stream);
    Args a{};
    a.x = (const float*)d_in[0]; a.c = (const float*)d_in[1]; a.pos = (const int*)d_in[2]; a.w_ada = (const float*)d_in[3]; a.b_ada = (const float*)d_in[4]; a.norm_g = (const float*)d_in[5];
    a.w_in = (const float*)d_in[6]; a.conv_w = (const float*)d_in[7]; a.conv_b = (const float*)d_in[8]; a.gate_b = (const float*)d_in[9]; a.ret_g = (const float*)d_in[10]; a.q_g = (const float*)d_in[11];
    a.k_g = (const float*)d_in[12]; a.sinks = (const float*)d_in[13]; a.rel_bias = (const float*)d_in[14]; a.w_up = (const float*)d_in[15]; a.w_out = (const float*)d_in[16]; a.w_ff1 = (const float*)d_in[17]; a.w_ff2 = (const float*)d_in[18];
    a.out = (float*)d_out; a.ws = (unsigned char*)d_ws;
    a.ph_lo = 0; a.ph_hi = N_PHASES; a.li = 0; a.probe = PROBE_MASK;
    hipLaunchKernelGGL(mega_fwd, dim3(grid), dim3(NTHR), LDS_BYTES, stream, a);
}
```

```cpp
#include <hip/hip_runtime.h>
#include <cstdio>
#include <cstdint>
#ifndef PROBE_MASK
#define PROBE_MASK 0
#endif

typedef unsigned short bf16_t;
typedef unsigned char u8;
#define LAS __attribute__((address_space(3)))
#define GAS __attribute__((address_space(1)))

constexpr int B_ = 2, S_ = 8192, D_ = 1024, L_ = 2, T_ = B_ * S_;
constexpr int DIN = 7432, NIN = 7424, NINP = 7680, NPM = 3328, NGT = 4096, DFF = 4096;
constexpr int NCH = 64;
constexpr int C_MQ = 0, C_MK = 256, C_MV = 512, C_MO = 768, C_RQ = 1024, C_RK = 1280, C_RV = 1536, C_RG = 1792,
              C_SQ = 2048, C_SK = 2304, C_SV = 2560, C_AQ = 2816, C_AK = 3072, C_AV = 3200;
constexpr size_t MiB = 1u << 20;
constexpr size_t WS_CTL = 0, CTL_ZERO_BYTES = 1 * MiB;
constexpr size_t WS_SSQ = 256 * 1024;
constexpr size_t WS_BIAS = 512 * 1024;
constexpr int BSTR = NINP + DFF;
constexpr size_t WS_MOD = 1 * MiB;
constexpr size_t WS_GS = 1 * MiB + 128 * 1024;
constexpr size_t WS_IF = 1 * MiB + 256 * 1024;
constexpr size_t WS_ST_ML = 2 * MiB, WS_ST_RT = 10 * MiB;
constexpr size_t WS_SMALL = 18 * MiB;
constexpr size_t WS_WIN = 19 * MiB;
constexpr size_t WS_WUP = WS_WIN + (size_t)NINP * 1024 * 2;
constexpr size_t WS_WOUT = WS_WUP + 2 * MiB;
constexpr size_t WS_W1 = WS_WOUT + 2 * MiB;
constexpr size_t WS_W2 = WS_W1 + 8 * MiB;
constexpr size_t WS_H = 54 * MiB;
constexpr size_t WS_PM = 86 * MiB;
constexpr size_t WS_GT = 190 * MiB;
constexpr size_t WS_HID = 86 * MiB;
constexpr size_t WS_H2 = 214 * MiB;
static_assert(WS_W2 + 8 * MiB <= WS_H, "weights fit below H");
constexpr int SM_NL = 0, SM_ML = 512 * 64, SM_AL = SM_ML + 512, SM_MI = SM_AL + 512;
constexpr int CW_BAR = 1024;

__device__ __forceinline__ float bf2f(bf16_t u) { return __uint_as_float(((unsigned)u) << 16); }
__device__ __forceinline__ bf16_t f2bf(float f) { unsigned u = __float_as_uint(f); return (bf16_t)((u + 0x7fffu + ((u >> 16) & 1u)) >> 16); }
__device__ __forceinline__ unsigned pk2(float lo, float hi) { return (unsigned)f2bf(lo) | ((unsigned)f2bf(hi) << 16); }
__device__ __forceinline__ float sigmoidf_(float x) { return 1.0f / (1.0f + expf(-x)); }
__device__ __forceinline__ float siluf_(float x) { return x / (1.0f + expf(-x)); }
__device__ __forceinline__ float logsigmoidf_(float x) { return fminf(x, 0.0f) - log1pf(expf(-fabsf(x))); }
__device__ __forceinline__ float wave_sum(float v) {
#pragma unroll
    for (int o = 1; o < 64; o <<= 1) v += __shfl_xor(v, o);
    return v;
}

typedef float f32x2_t_ __attribute__((ext_vector_type(2))); typedef __bf16 bf16x2_t_ __attribute__((ext_vector_type(2)));
__device__ __forceinline__ unsigned cvt_pk_visible(float lo, float hi) { f32x2_t_ v = {lo, hi}; bf16x2_t_ b = __builtin_convertvector(v, bf16x2_t_); return __builtin_bit_cast(unsigned, b); }
namespace pg8 {
typedef short bf16x8 __attribute__((ext_vector_type(8)));
typedef float f32x4 __attribute__((ext_vector_type(4)));
typedef unsigned u32x4 __attribute__((ext_vector_type(4)));
typedef unsigned u32x2 __attribute__((ext_vector_type(2)));
constexpr int BM = 256, BK = 64, HALF = 128, HTB = HALF * BK * 2, STAGE_BYTES = 8 * HTB, NXCD = 8, WGM = 8;
__host__ __device__ __forceinline__ int lds_byte(int r, int c) { const int st = (r >> 4) * 2 + (c >> 5), rr = r & 15, cc = c & 31, ob = rr * 64 + cc * 2; return st * 1024 + (ob ^ (((ob >> 9) & 1) << 5)); }
__host__ __device__ __forceinline__ void stage_rc(int b, int& R, int& C) { const int st = b / 1024, sb = b % 1024, swz = sb ^ (((sb >> 9) & 1) << 5); R = (st >> 1) * 16 + swz / 64; C = (st & 1) * 32 + (swz % 64) / 2; }
__host__ __device__ __forceinline__ int perm32(int rho) { const int n = rho >> 4, i = rho & 15; return 8 * (i >> 2) + 4 * n + (i & 3); }

struct Unit { int pm, pn, z; };
struct Gemm { const bf16_t* A; const bf16_t* Bt; };

struct StaticOrder {
    int nM, nN, nwg, G, c;
    __device__ void init(int M, int N, int G_, int c_) { nM = M / BM; nN = N / BM; nwg = nM * nN; G = G_; c = c_; }
    __device__ bool tile(long Lx, Unit& u) const {
        if (Lx >= nwg) return false;
        int wgid = (int)Lx; { const int q = nwg / NXCD, r = nwg % NXCD, xcd = wgid % NXCD, off = wgid / NXCD; wgid = (xcd < r ? xcd * (q + 1) : r * (q + 1) + (xcd - r) * q) + off; }
        const int nig = WGM * nN, gid = wgid / nig, fm = gid * WGM, gsz = (nM - fm) < WGM ? (nM - fm) : WGM;
        u.pm = fm + ((wgid % nig) % gsz); u.pn = (wgid % nig) / gsz; u.z = 0; return true;
    }
    __device__ bool next(int i, Unit& u) const { return tile((long)i * G + c, u); }
    template <int LDA, int KK> __device__ const char* a_base(const Gemm& g, const Unit& u) const { return (const char*)g.A + (size_t)u.pm * BM * LDA * 2; }
    template <int LDA, int KK> __device__ const char* b_base(const Gemm& g, const Unit& u) const { return (const char*)g.Bt + (size_t)u.pn * BM * KK * 2; }
};
struct UpOrder {
    StaticOrder so;
    __device__ bool next(int i, Unit& u) const { if (!so.tile((long)(i >> 2) * so.G + so.c, u)) return false; u.z = i & 3; return true; }
    template <int LDA, int KK> __device__ const char* a_base(const Gemm& g, const Unit& u) const { const int ac = (u.z == 0) ? C_MO : (u.z == 1) ? C_RG : (u.z == 2) ? C_SQ : C_AQ; return (const char*)g.A + ((size_t)u.pm * BM * LDA + ac) * 2; }
    template <int LDA, int KK> __device__ const char* b_base(const Gemm& g, const Unit& u) const { return (const char*)g.Bt + ((size_t)u.z * 1024 + (size_t)u.pn * BM) * KK * 2; }
};

__device__ __forceinline__ unsigned cvt_pk_bf16(float lo, float hi) { return cvt_pk_visible(lo, hi); }

struct EpiIn {
    static constexpr bool PERM = true;
    unsigned char* ws; const float* gate_b; int l;
    __device__ __forceinline__ void operator()(const f32x4 (&acc)[2][2][4][2], const Unit& u, int wr, int wc, int fr, int fq) const {
        bf16_t* PM = (bf16_t*)(ws + WS_PM); u8* GT = (u8*)(ws + WS_GT); float* IF = (float*)(ws + WS_IF); const float* ssq = (const float*)(ws + WS_SSQ) + (size_t)(l * 2) * T_; const float* bias = (const float*)(ws + WS_BIAS) + (size_t)l * B_ * BSTR;
        const int row0 = u.pm * BM + wr * 64 + fr, cl0 = wc * 32 + 8 * fq; const int b = (u.pm * BM) / S_;
        const float* bp = bias + (size_t)b * BSTR + u.pn * BM + cl0;
        if (u.pn == 29) {
            if (wc == 0 && fq == 0) { const f32x4 b0 = *(const f32x4*)bp + *(const f32x4*)gate_b, b1 = *(const f32x4*)(bp + 4) + *(const f32x4*)(gate_b + 4);
#pragma unroll
                for (int ai = 0; ai < 2; ++ai)
#pragma unroll
                    for (int m = 0; m < 4; ++m) { const int r = row0 + ai * HALF + m * 16; const float rs = 1.0f / sqrtf(ssq[r] * (1.0f / D_) + 1e-6f);
                        *(f32x4*)(IF + (size_t)r * 8) = acc[ai][0][m][0] * rs + b0; *(f32x4*)(IF + (size_t)r * 8 + 4) = acc[ai][0][m][1] * rs + b1; } }
            return;
        }
        float rs[2][4];
#pragma unroll
        for (int ai = 0; ai < 2; ++ai)
#pragma unroll
            for (int m = 0; m < 4; ++m) rs[ai][m] = 1.0f / sqrtf(ssq[row0 + ai * HALF + m * 16] * (1.0f / D_) + 1e-6f);
        if (u.pn < 13) {
            const int col0 = u.pn * BM + cl0;
#pragma unroll
            for (int bj = 0; bj < 2; ++bj) { const f32x4 b0 = *(const f32x4*)(bp + bj * HALF), b1 = *(const f32x4*)(bp + bj * HALF + 4);
#pragma unroll
                for (int ai = 0; ai < 2; ++ai)
#pragma unroll
                    for (int m = 0; m < 4; ++m) { const f32x4 v0 = acc[ai][bj][m][0] * rs[ai][m] + b0, v1 = acc[ai][bj][m][1] * rs[ai][m] + b1;
                        u32x4 w; w.x = cvt_pk_bf16(v0[0], v0[1]); w.y = cvt_pk_bf16(v0[2], v0[3]); w.z = cvt_pk_bf16(v1[0], v1[1]); w.w = cvt_pk_bf16(v1[2], v1[3]);
                        *(u32x4*)(PM + (size_t)(row0 + ai * HALF + m * 16) * NPM + col0 + bj * HALF) = w; }
                asm volatile("" ::: "memory"); }
        } else {
            const int col0 = (u.pn - 13) * BM + cl0;
#pragma unroll
            for (int bj = 0; bj < 2; ++bj) { const f32x4 b0 = *(const f32x4*)(bp + bj * HALF), b1 = *(const f32x4*)(bp + bj * HALF + 4);
#pragma unroll
                for (int ai = 0; ai < 2; ++ai)
#pragma unroll
                    for (int m = 0; m < 4; ++m) { unsigned q[8];
#pragma unroll
                        for (int j = 0; j < 4; ++j) { const float s0 = __builtin_amdgcn_rcpf(1.0f + __expf(-(acc[ai][bj][m][0][j] * rs[ai][m] + b0[j]))), s1 = __builtin_amdgcn_rcpf(1.0f + __expf(-(acc[ai][bj][m][1][j] * rs[ai][m] + b1[j])));
                            q[j] = (unsigned)(s0 * 255.0f + 0.5f); q[4 + j] = (unsigned)(s1 * 255.0f + 0.5f); }
                        u32x2 w; w.x = q[0] | (q[1] << 8) | (q[2] << 16) | (q[3] << 24); w.y = q[4] | (q[5] << 8) | (q[6] << 16) | (q[7] << 24);
                        *(u32x2*)(GT + (size_t)(row0 + ai * HALF + m * 16) * NGT + col0 + bj * HALF) = w; }
                asm volatile("" ::: "memory"); }
        }
    }
};
struct EpiUp {
    static constexpr bool PERM = true;
    bf16_t* H; const u8* GT; bool dry;
    __device__ __forceinline__ void operator()(const f32x4 (&acc)[2][2][4][2], const Unit& u, int wr, int wc, int fr, int fq) const {
        const int row0 = u.pm * BM + wr * 64 + fr, col0 = u.pn * BM + wc * 32 + 8 * fq;
#pragma unroll
        for (int ai = 0; ai < 2; ++ai)
#pragma unroll
            for (int m = 0; m < 4; ++m) { const size_t r = (size_t)(row0 + ai * HALF + m * 16);
#pragma unroll
                for (int bj = 0; bj < 2; ++bj) {
                    const u32x2 gq = *(const u32x2*)(GT + r * NGT + u.z * 1024 + col0 + bj * HALF);
                    bf16_t* hp = H + r * D_ + col0 + bj * HALF;
                    float o[8];
#pragma unroll
                    for (int j = 0; j < 8; ++j) { const unsigned gb = ((j < 4 ? gq.x : gq.y) >> (8 * (j & 3))) & 0xffu; o[j] = (float)gb * (1.0f / 255.0f) * acc[ai][bj][m][j >> 2][j & 3]; }
                    if (u.z != 0) { const u32x4 old = *(const u32x4*)hp;
#pragma unroll
                        for (int j = 0; j < 4; ++j) { o[2 * j] += __uint_as_float(old[j] << 16); o[2 * j + 1] += __uint_as_float(old[j] & 0xffff0000u); } }
                    u32x4 w; w.x = cvt_pk_bf16(o[0], o[1]); w.y = cvt_pk_bf16(o[2], o[3]); w.z = cvt_pk_bf16(o[4], o[5]); w.w = cvt_pk_bf16(o[6], o[7]);
                    if (!dry) *(u32x4*)hp = w; }
                if (m & 1) asm volatile("" ::: "memory"); }
    }
};
struct EpiRes {
    static constexpr bool PERM = false;
    const float* xin; float* xout; const float* gate; const float* gs; bf16_t* An; float* ssq; bool dry;
    __device__ __forceinline__ void operator()(const f32x4 (&acc)[2][2][4][2], const Unit& u, int wr, int wc, int fr, int fq) const {
        const int row0 = u.pm * BM + wr * 64 + fr, col0 = u.pn * BM + wc * 32 + 4 * fq; const int b = (u.pm * BM) / S_;
        float ss[2][4];
#pragma unroll
        for (int ai = 0; ai < 2; ++ai)
#pragma unroll
            for (int m = 0; m < 4; ++m) ss[ai][m] = 0.f;
#pragma unroll
        for (int bj = 0; bj < 2; ++bj)
#pragma unroll
            for (int n = 0; n < 2; ++n) { const int cc = col0 + bj * HALF + n * 16;
                const f32x4 gv = *(const f32x4*)(gate + (size_t)b * 6144 + cc); const f32x4 sv = gs ? *(const f32x4*)(gs + (size_t)b * 1024 + cc) : (f32x4){0.f, 0.f, 0.f, 0.f};
#pragma unroll
                for (int ai = 0; ai < 2; ++ai) {
#pragma unroll
                    for (int m = 0; m < 4; ++m) { const size_t off = (size_t)(row0 + ai * HALF + m * 16) * D_ + cc;
                        const f32x4 xi = *(const f32x4*)(xin + off); const f32x4 xo = xi + gv * acc[ai][bj][m][n];
                        if (!dry) *(f32x4*)(xout + off) = xo;
                        if (gs) { ss[ai][m] += (xo[0] * xo[0] + xo[1] * xo[1]) + (xo[2] * xo[2] + xo[3] * xo[3]); const f32x4 a4 = xo * sv;
                            u32x2 w; w.x = cvt_pk_bf16(a4[0], a4[1]); w.y = cvt_pk_bf16(a4[2], a4[3]); if (!dry) *(u32x2*)(An + off) = w; } } }
                asm volatile("" ::: "memory"); }
        if (gs) {
#pragma unroll
            for (int ai = 0; ai < 2; ++ai)
#pragma unroll
                for (int m = 0; m < 4; ++m) { float t = ss[ai][m]; t += __shfl_xor(t, 16); t += __shfl_xor(t, 32); if (fq == 0 && !dry) atomicAdd(ssq + row0 + ai * HALF + m * 16, t); } }
    }
};
struct EpiFF1 {
    static constexpr bool PERM = true;
    bf16_t* HID; const float* ssq; const float* bias;
    __device__ __forceinline__ void operator()(const f32x4 (&acc)[2][2][4][2], const Unit& u, int wr, int wc, int fr, int fq) const {
        const int row0 = u.pm * BM + wr * 64 + fr, col0 = u.pn * BM + wc * 32 + 8 * fq; const int b = (u.pm * BM) / S_;
        f32x4 bv[2][2];
#pragma unroll
        for (int bj = 0; bj < 2; ++bj)
#pragma unroll
            for (int n = 0; n < 2; ++n) bv[bj][n] = *(const f32x4*)(bias + (size_t)b * BSTR + col0 + bj * HALF + 4 * n);
#pragma unroll
        for (int ai = 0; ai < 2; ++ai)
#pragma unroll
            for (int m = 0; m < 4; ++m) { const int r = row0 + ai * HALF + m * 16; const float rs = 1.0f / sqrtf(ssq[r] * (1.0f / D_) + 1e-6f); bf16_t* rowp = HID + (size_t)r * DFF + col0;
#pragma unroll
                for (int bj = 0; bj < 2; ++bj) { f32x4 v0 = acc[ai][bj][m][0] * rs + bv[bj][0], v1 = acc[ai][bj][m][1] * rs + bv[bj][1];
#pragma unroll
                    for (int j = 0; j < 4; ++j) { const float a = fmaxf(v0[j], 0.f), c = fmaxf(v1[j], 0.f); v0[j] = a * a; v1[j] = c * c; }
                    u32x4 w; w.x = cvt_pk_bf16(v0[0], v0[1]); w.y = cvt_pk_bf16(v0[2], v0[3]); w.z = cvt_pk_bf16(v1[0], v1[1]); w.w = cvt_pk_bf16(v1[2], v1[3]);
                    *(u32x4*)(rowp + bj * HALF) = w; } }
    }
};

template <int LDA, int KK, class Epi, class Sched>
__device__ __forceinline__ void gemm_phase(LAS unsigned char* lds, const Gemm g, const Sched& S, const Epi& E) {
    int tid = threadIdx.x; asm volatile("" : "+v"(tid));
    const int wid = __builtin_amdgcn_readfirstlane(tid >> 6), lane = tid & 63, wr = wid >> 2, wc = wid & 3, fr = lane & 15, fq = lane >> 4;
    constexpr int K = KK, nt = K / BK, lda = LDA;
    unsigned voffA[2], voffB[2];
#pragma unroll
    for (int i = 0; i < 2; ++i) { int R, C; stage_rc(tid * 16 + i * 8192, R, C); const int Rb = Epi::PERM ? ((R & ~31) + perm32(R & 31)) : R;
        voffA[i] = (unsigned)(R * lda + C) * 2u; voffB[i] = (unsigned)(Rb * K + C) * 2u; }
    constexpr size_t kstep = (size_t)(BK * 2);
    constexpr size_t hstepA = (size_t)HALF * lda * 2, hstepB = (size_t)HALF * K * 2;
    const unsigned ldsw = (unsigned)wid * 1024u;
    const int aoff = lds_byte(wr * 64 + fr, fq * 8), boff = lds_byte(wc * 32 + fr, fq * 8);
#define PG8_SA(b, h) (((b) * 2 + (h)) * HTB)
#define PG8_SB(b, h) ((4 + (b) * 2 + (h)) * HTB)
#define PG8_STAGE(bufoff, gbase, voff) do { _Pragma("unroll") for (int _i = 0; _i < 2; ++_i) \
        __builtin_amdgcn_global_load_lds((const unsigned*)((const char*)(gbase) + (voff)[_i]), (LAS unsigned*)(lds + (bufoff) + ldsw + _i * 8192), 16, 0, 0); } while (0)
#define PG8_LDA(dst, b, h) do { _Pragma("unroll") for (int m = 0; m < 4; ++m) _Pragma("unroll") for (int k = 0; k < 2; ++k) dst[m][k] = *(const LAS bf16x8*)(lds + PG8_SA(b, h) + aoff + m * 2048 + k * 1024); } while (0)
#define PG8_LDB(dst, b, h) do { _Pragma("unroll") for (int n = 0; n < 2; ++n) _Pragma("unroll") for (int k = 0; k < 2; ++k) dst[n][k] = *(const LAS bf16x8*)(lds + PG8_SB(b, h) + boff + n * 2048 + k * 1024); } while (0)
#define PG8_MMA(ai, bj, At, Bt) do { __builtin_amdgcn_s_setprio(1); _Pragma("unroll") for (int m = 0; m < 4; ++m) _Pragma("unroll") for (int n = 0; n < 2; ++n) _Pragma("unroll") for (int k = 0; k < 2; ++k) \
        acc[ai][bj][m][n] = __builtin_amdgcn_mfma_f32_16x16x32_bf16(Bt[n][k], At[m][k], acc[ai][bj][m][n], 0, 0, 0); __builtin_amdgcn_s_setprio(0); } while (0)
#define PG8_WAIT_V(n) asm volatile("s_waitcnt vmcnt(" #n ")" ::: "memory")
#define PG8_WAIT_L(n) asm volatile("s_waitcnt lgkmcnt(" #n ")" ::: "memory")
#define PG8_BAR __builtin_amdgcn_s_barrier()
#define PG8_SCHED __builtin_amdgcn_sched_barrier(0)
    Unit cur, nxt; int ui = 0;
    if (!S.next(0, cur)) return;
    f32x4 acc[2][2][4][2];
#pragma unroll
    for (int a = 0; a < 2; ++a)
#pragma unroll
        for (int b = 0; b < 2; ++b)
#pragma unroll
            for (int m = 0; m < 4; ++m)
#pragma unroll
                for (int n = 0; n < 2; ++n) acc[a][b][m][n] = (f32x4){0.f, 0.f, 0.f, 0.f};
    bf16x8 At[4][2], B0[2][2], B1[2][2];
    const char* cA = S.template a_base<LDA, KK>(g, cur); const char* cB = S.template b_base<LDA, KK>(g, cur);
    PG8_STAGE(PG8_SB(0, 0), cB, voffB); PG8_STAGE(PG8_SB(0, 1), cB + hstepB, voffB); PG8_STAGE(PG8_SA(0, 0), cA, voffA); PG8_STAGE(PG8_SA(0, 1), cA + hstepA, voffA);
    if (wr == 1) PG8_BAR;
    PG8_WAIT_V(2); PG8_BAR;
    PG8_STAGE(PG8_SB(1, 0), cB + kstep, voffB); PG8_STAGE(PG8_SA(1, 0), cA + kstep, voffA); PG8_STAGE(PG8_SB(1, 1), cB + hstepB + kstep, voffB);
    PG8_WAIT_V(6); PG8_BAR;
    for (;;) {
        const bool has_next = S.next(ui + 1, nxt);
        const char* nA = has_next ? S.template a_base<LDA, KK>(g, nxt) : cA; const char* nB = has_next ? S.template b_base<LDA, KK>(g, nxt) : cB;
#pragma nounroll
        for (int t = 0; t < nt; t += 2) {
            const bool last = (t == nt - 2);
            const char* a1 = cA + (size_t)(t + 1) * kstep;
            const char* a2 = last ? nA : cA + (size_t)(t + 2) * kstep; const char* b2 = last ? nB : cB + (size_t)(t + 2) * kstep;
            const char* a3 = a2 + kstep; const char* b3 = b2 + kstep;
            PG8_LDB(B0, 0, 0); PG8_LDB(B1, 0, 1); PG8_SCHED; PG8_LDA(At, 0, 0); PG8_STAGE(PG8_SA(1, 1), a1 + hstepA, voffA);
            PG8_WAIT_V(8); PG8_WAIT_L(0); PG8_BAR; PG8_MMA(0, 0, At, B0); PG8_MMA(0, 1, At, B1); PG8_BAR; PG8_SCHED;
            PG8_LDA(At, 0, 1); PG8_STAGE(PG8_SB(0, 0), b2, voffB); PG8_STAGE(PG8_SB(0, 1), b2 + hstepB, voffB); PG8_STAGE(PG8_SA(0, 0), a2, voffA);
            PG8_WAIT_V(8); PG8_WAIT_L(0); PG8_BAR; PG8_MMA(1, 0, At, B0); PG8_MMA(1, 1, At, B1); PG8_BAR; PG8_SCHED;
            PG8_LDB(B0, 1, 0); PG8_LDB(B1, 1, 1); PG8_SCHED; PG8_LDA(At, 1, 0); PG8_STAGE(PG8_SA(0, 1), a2 + hstepA, voffA);
            PG8_WAIT_V(8); PG8_WAIT_L(0); PG8_BAR; PG8_MMA(0, 0, At, B0); PG8_MMA(0, 1, At, B1); PG8_BAR; PG8_SCHED;
            PG8_LDA(At, 1, 1); PG8_STAGE(PG8_SB(1, 0), b3, voffB); PG8_STAGE(PG8_SB(1, 1), b3 + hstepB, voffB); PG8_STAGE(PG8_SA(1, 0), a3, voffA);
            PG8_WAIT_V(8); PG8_WAIT_L(0); PG8_BAR; PG8_MMA(1, 0, At, B0); PG8_MMA(1, 1, At, B1); PG8_BAR; PG8_SCHED;
        }
        if (wr == 0) PG8_BAR;
        E(acc, cur, wr, wc, fr, fq);
        if (!has_next) break;
#pragma unroll
        for (int a = 0; a < 2; ++a)
#pragma unroll
            for (int b = 0; b < 2; ++b)
#pragma unroll
                for (int m = 0; m < 4; ++m)
#pragma unroll
                    for (int n = 0; n < 2; ++n) acc[a][b][m][n] = (f32x4){0.f, 0.f, 0.f, 0.f};
        cur = nxt; cA = nA; cB = nB; ++ui;
        if (wr == 1) PG8_BAR;
    }
    PG8_WAIT_V(0);
    PG8_BAR;
#undef PG8_SA
#undef PG8_SB
#undef PG8_STAGE
#undef PG8_LDA
#undef PG8_LDB
#undef PG8_MMA
#undef PG8_WAIT_V
#undef PG8_WAIT_L
#undef PG8_BAR
#undef PG8_SCHED
}
}

#define XB_TMO      128
#define XB_XCNT(j)  (256  + 64 * (j))
#define XB_XSUB(j)  (1280 + 64 * (j))
#define XB_XGEN(j)  (2304 + 64 * (j))
#define XB_TOP      3328
#define XB_TOPGEN   3392
#define XCD_BAR_WORDS 3456
#define XB_SPIN_CAP (1u << 25)
__device__ __forceinline__ unsigned xb_ld(unsigned* p)              { return __hip_atomic_load(p, __ATOMIC_RELAXED, __HIP_MEMORY_SCOPE_AGENT); }
__device__ __forceinline__ unsigned xb_add(unsigned* p, unsigned v) { return __hip_atomic_fetch_add(p, v, __ATOMIC_RELAXED, __HIP_MEMORY_SCOPE_AGENT); }
__device__ __forceinline__ unsigned xb_xcc_id() { return (unsigned)__builtin_amdgcn_s_getreg((3 << 11) | 20) & 0xFu; }
#define XB_SPIN(cond, bar) do { unsigned _sp = 0; while (cond) { __builtin_amdgcn_s_sleep(1); \
    if ((++_sp & 255u) == 0u) { if (xb_ld(&(bar)[XB_TMO])) break; if (_sp > XB_SPIN_CAP) { atomicAdd(&(bar)[XB_TMO], 1u); break; } } } } while (0)
struct XcdBarrier { unsigned* bar; unsigned x; volatile LAS unsigned* st; };
__device__ __forceinline__ XcdBarrier xcd_barrier_post(unsigned* bar, volatile LAS unsigned* st) {
    XcdBarrier b; b.bar = bar; b.x = xb_xcc_id(); b.st = st;
    if (threadIdx.x == 0) (void)xb_add(&bar[XB_XCNT(b.x)], 1u);
    return b;
}
__device__ __forceinline__ void xcd_barrier_complete(unsigned* bar, unsigned x, unsigned& nloc, unsigned& nx) {
    const unsigned G = gridDim.x * gridDim.y * gridDim.z;
    unsigned sum, cnt, mine, sp = 0u;
    for (;;) {
        sum = 0u; cnt = 0u; mine = 0u;
#pragma unroll
        for (unsigned j = 0; j < 16; ++j) { const unsigned c = xb_ld(&bar[XB_XCNT(j)]); sum += c; cnt += (c > 0u) ? 1u : 0u; mine = (j == x) ? c : mine; }
        if (sum == G) break;
        __builtin_amdgcn_s_sleep(1);
        if ((++sp & 255u) == 0u) { if (xb_ld(&bar[XB_TMO])) break; if (sp > XB_SPIN_CAP) { atomicAdd(&bar[XB_TMO], 1u); break; } }
    }
    nloc = mine > 0u ? mine : 1u; nx = cnt > 0u ? cnt : 1u;
}
__device__ __forceinline__ void xcd_barrier(const XcdBarrier& b) {
    asm volatile("s_waitcnt vmcnt(0)" ::: "memory");
    __syncthreads();
    if (threadIdx.x == 0) {
        unsigned* bar = b.bar;
        __builtin_amdgcn_s_waitcnt(0);
        unsigned nloc = b.st[0], nx = b.st[1]; const unsigned k = b.st[2];
        if (nloc == 0u) { xcd_barrier_complete(bar, b.x, nloc, nx); b.st[0] = nloc; b.st[1] = nx; }
        const unsigned old = xb_add(&bar[XB_XSUB(b.x)], 1u);
        if (old + 1u == (old / nloc + 1u) * nloc) {
            __builtin_amdgcn_fence(__ATOMIC_RELEASE, "agent");
            asm volatile("s_waitcnt vmcnt(0)" ::: "memory");
            const unsigned og = xb_add(&bar[XB_TOP], 1u);
            if (og + 1u == (k + 1u) * nx) xb_add(&bar[XB_TOPGEN], 1u);
        }
        XB_SPIN(xb_ld(&bar[XB_TOPGEN]) == k, bar);
        __builtin_amdgcn_fence(__ATOMIC_ACQUIRE, "agent");
        asm volatile("s_waitcnt vmcnt(0)" ::: "memory");
        b.st[2] = k + 1u;
    }
    __syncthreads();
}

struct Args {
    const float* x; const float* c; const int* pos; const float* w_ada; const float* b_ada; const float* norm_g; const float* w_in;
    const float* conv_w; const float* conv_b; const float* gate_b; const float* ret_g; const float* q_g; const float* k_g; const float* sinks; const float* rel_bias;
    const float* w_up; const float* w_out; const float* w_ff1; const float* w_ff2; float* out; unsigned char* ws;
    int ph_lo, ph_hi, li, probe;
};
typedef const __attribute__((address_space(4))) Args* KArgs;
__device__ __forceinline__ KArgs kargs() { KArgs p = (KArgs)__builtin_amdgcn_kernarg_segment_ptr(); asm volatile("" : "+s"(p)); return p; }
constexpr int NWAVES = 8, NTHR = 512;
constexpr int RING_BYTES = 155648, LDSCTL_OFF = RING_BYTES, MISC_OFF = LDSCTL_OFF + 320, LDS_BYTES = 163840;

__device__ __forceinline__ void transpose64(const float* W, int ldw, int col0, int valid, bf16_t* WT, int wt_row0, int K, int k0, LAS float* scr, int lane, const float* sh, float* bias, bool dry = false) {
    const int n4 = (lane & 15) * 4, kr = lane >> 4;
    float4 v[16];
#pragma unroll
    for (int i = 0; i < 16; ++i) v[i] = (n4 < valid) ? *(const float4*)(W + (size_t)(k0 + 4 * i + kr) * ldw + col0 + n4) : make_float4(0.f, 0.f, 0.f, 0.f);
#pragma unroll
    for (int i = 0; i < 16; ++i) { LAS float* dp = scr + (4 * i + kr) * 68 + n4; *(LAS pg8::f32x4*)dp = (pg8::f32x4){v[i].x, v[i].y, v[i].z, v[i].w}; }
    asm volatile("s_waitcnt lgkmcnt(0)" ::: "memory");
    const int c = lane & 7;
#pragma unroll
    for (int j = 0; j < 8; ++j) { const int n = (lane >> 3) + 8 * j; const LAS float* sp = scr + (8 * c) * 68 + n;
        pg8::u32x4 o; o.x = pk2(sp[0 * 68], sp[1 * 68]); o.y = pk2(sp[2 * 68], sp[3 * 68]); o.z = pk2(sp[4 * 68], sp[5 * 68]); o.w = pk2(sp[6 * 68], sp[7 * 68]);
        if (!dry) *(pg8::u32x4*)(WT + (size_t)(wt_row0 + n) * K + k0 + 8 * c) = o; else asm volatile("" :: "v"(o)); }
    if (sh) { float a0 = 0.f, a1 = 0.f;
#pragma unroll 16
        for (int kk = 0; kk < 64; ++kk) { const float w = scr[kk * 68 + lane]; a0 += w * sh[k0 + kk]; a1 += w * sh[6144 + k0 + kk]; }
        if (dry) asm volatile("" :: "v"(a0), "v"(a1)); else if (lane < valid) { atomicAdd(bias + wt_row0 + lane, a0); atomicAdd(bias + BSTR + wt_row0 + lane, a1); } }
    asm volatile("s_waitcnt lgkmcnt(0)" ::: "memory");
}
__device__ __forceinline__ void convert_weights(const float* w_in, const float* w_up, const float* w_out, const float* w_ff1, const float* w_ff2, unsigned char* ws, int l, LAS unsigned char* lds, int gw, int NGW, int wave, int lane, bool dry = false) {
    LAS float* scr = (LAS float*)(lds + wave * 17408);
    bf16_t* WinT = (bf16_t*)(ws + WS_WIN); bf16_t* WupT = (bf16_t*)(ws + WS_WUP); bf16_t* WoutT = (bf16_t*)(ws + WS_WOUT); bf16_t* W1T = (bf16_t*)(ws + WS_W1); bf16_t* W2T = (bf16_t*)(ws + WS_W2);
    const float* sh1 = (const float*)(ws + WS_MOD) + (size_t)l * B_ * 2 * 3072;
    float* bias = (float*)(ws + WS_BIAS) + (size_t)l * B_ * BSTR;
    constexpr int I_IN = 16 * (NIN / 64), I_IF = 16, I_Z = 384, I_UP = 4 * 4 * 16, I_OUT = 16 * 16, I_1 = 16 * 64, I_2 = 64 * 16;
    constexpr int NITEMS = I_IN + I_IF + I_Z + I_UP + I_OUT + I_1 + I_2;
    for (int it = gw; it < NITEMS; it += NGW) {
        int r = it;
        if (r < I_IN) { const int nblk = NIN / 64, kb = r / nblk, nb = r % nblk; transpose64(w_in + (size_t)l * D_ * DIN, DIN, 64 * nb + ((nb * 64 >= 768) ? 8 : 0), 64, WinT, 64 * nb, D_, 64 * kb, scr, lane, sh1, bias, dry); continue; } r -= I_IN;
        if (r < I_IF) { transpose64(w_in + (size_t)l * D_ * DIN, DIN, 768, 8, WinT, NIN, D_, 64 * r, scr, lane, sh1, bias, dry); continue; } r -= I_IF;
        if (r < I_Z) { if (dry) continue; unsigned z = 0u; asm volatile("" : "+v"(z)); *(pg8::u32x4*)(WinT + (size_t)(NIN + 64) * D_ + (size_t)r * 512 + lane * 8) = (pg8::u32x4){z, z, z, z}; continue; } r -= I_Z;
        if (r < I_UP) { const int z = r / 64, rr = r % 64, kb = rr / 16, nb = rr % 16; transpose64(w_up + ((size_t)l * 4 + z) * 256 * 1024, 1024, 64 * nb, 64, WupT, z * 1024 + 64 * nb, 256, 64 * kb, scr, lane, nullptr, nullptr, dry); continue; } r -= I_UP;
        if (r < I_OUT) { transpose64(w_out + (size_t)l * D_ * D_, D_, 64 * (r % 16), 64, WoutT, 64 * (r % 16), D_, 64 * (r / 16), scr, lane, nullptr, nullptr, dry); continue; } r -= I_OUT;
        if (r < I_1) { transpose64(w_ff1 + (size_t)l * D_ * DFF, DFF, 64 * (r % 64), 64, W1T, 64 * (r % 64), D_, 64 * (r / 64), scr, lane, sh1 + 3072, bias + NINP, dry); continue; } r -= I_1;
        transpose64(w_ff2 + (size_t)l * DFF * D_, D_, 64 * (r % 16), 64, W2T, 64 * (r % 16), DFF, 64 * (r / 16), scr, lane, nullptr, nullptr, dry);
    }
}
__device__ __forceinline__ void gs_phase(const float* norm_g, const float* MOD, float* GS, int gtid, int NT) {
    for (int i = gtid; i < L_ * 2 * B_ * 1024; i += NT) { const int d = i & 1023, b = (i >> 10) & 1, j = (i >> 11) & 1, l = i >> 12;
        GS[i] = norm_g[(size_t)(l * 2 + j) * D_ + d] * (1.0f + MOD[(((size_t)l * 2 + b) * 2 + j) * 3072 + 1024 + d]); }
}
__device__ __forceinline__ void xprep_phase(const float* x, const float* g, const float* mod0  , bf16_t* H, float* ssq, int gw, int NGW, int lane, bool dry = false) {
    for (int m = gw; m < T_; m += NGW) {
        const int b = m / S_; const float* xr = x + (size_t)m * D_; const float* scale = mod0 + (size_t)b * 6144 + 1024;
        float ss = 0.f;
#pragma unroll
        for (int i = 0; i < 4; ++i) { const float4 t = *(const float4*)(xr + i * 256 + lane * 4); const float4 g4 = *(const float4*)(g + i * 256 + lane * 4), sc4 = *(const float4*)(scale + i * 256 + lane * 4);
            ss += t.x * t.x + t.y * t.y + t.z * t.z + t.w * t.w;
            uint2 o; o.x = pk2(t.x * g4.x * (1.0f + sc4.x), t.y * g4.y * (1.0f + sc4.y)); o.y = pk2(t.z * g4.z * (1.0f + sc4.z), t.w * g4.w * (1.0f + sc4.w));
            if (!dry) *(uint2*)(H + (size_t)m * D_ + i * 256 + lane * 4) = o; else asm volatile("" :: "v"(o.x), "v"(o.y)); }
        ss = wave_sum(ss);
        if (lane == 0 && !dry) ssq[m] = ss;
    }
}
__device__ __forceinline__ void mod_phase(const float* c, const float* w_ada, float* MODP, LAS unsigned char* lds, int bid, int G, int tid) {
    LAS float* cact = (LAS float*)lds;
    LAS float* red = cact + 2048;
    __syncthreads();
    for (int i = tid; i < 2048; i += NTHR) cact[i] = siluf_(c[i]);
    __syncthreads();
    for (int it = bid; it < L_ * 2 * 12 * 8; it += G) {
        const int dblk = it & 7, cblk = (it >> 3) % 12, lj = it / 96, e0 = cblk * 256, c4 = tid & 63, ds = tid >> 6, d0 = dblk * 128 + ds * 16;
        const float* w = w_ada + ((size_t)lj * 1024 + d0) * 3072 + e0 + 4 * c4;
        float4 wv[16];
#pragma unroll
        for (int i = 0; i < 16; ++i) wv[i] = *(const float4*)(w + (size_t)i * 3072);
        float a0[4] = {0.f, 0.f, 0.f, 0.f}, a1[4] = {0.f, 0.f, 0.f, 0.f};
#pragma unroll
        for (int i = 0; i < 16; ++i) { const float s0 = cact[d0 + i], s1 = cact[1024 + d0 + i];
            a0[0] += s0 * wv[i].x; a0[1] += s0 * wv[i].y; a0[2] += s0 * wv[i].z; a0[3] += s0 * wv[i].w; a1[0] += s1 * wv[i].x; a1[1] += s1 * wv[i].y; a1[2] += s1 * wv[i].z; a1[3] += s1 * wv[i].w; }
        LAS float* rp = red + (ds * 64 + c4) * 8;
#pragma unroll
        for (int k = 0; k < 4; ++k) { rp[k] = a0[k]; rp[4 + k] = a1[k]; }
        __syncthreads();
        { const int v = tid & 7, cc = tid >> 3, b = v >> 2, k = v & 3; float t = 0.f;
#pragma unroll
          for (int q = 0; q < 8; ++q) t += red[(q * 64 + cc) * 8 + v];
          const int l = lj >> 1, j = lj & 1, e = e0 + 4 * cc + k;
          MODP[(size_t)dblk * (L_ * B_ * 2 * 3072) + (((size_t)l * 2 + b) * 2 + j) * 3072 + e] = t; }
        __syncthreads();
    }
}
__device__ __forceinline__ void mod_reduce(const float* MODP, const float* b_ada, float* MOD, int gtid, int NT) {
    for (int i = gtid; i < L_ * B_ * 2 * 3072; i += NT) { const int e = i % 3072, j = (i / 3072) & 1, l = i / 12288; float t = b_ada[(size_t)(l * 2 + j) * 3072 + e];
#pragma unroll
        for (int q = 0; q < 8; ++q) t += MODP[(size_t)q * (L_ * B_ * 2 * 3072) + i];
        MOD[i] = t; }
}
namespace sbk {
typedef short bf16x8 __attribute__((ext_vector_type(8)));
typedef short s16x4 __attribute__((ext_vector_type(4)));
typedef float f32x16 __attribute__((ext_vector_type(16)));
typedef unsigned u32x4 __attribute__((ext_vector_type(4)));
typedef unsigned u32x2 __attribute__((ext_vector_type(2)));
constexpr int ROWB = 144, TILEB = 9728;
__device__ __forceinline__ int rowoff(int key) { return key * ROWB + (key >> 5) * 16; }
__device__ __forceinline__ s16x4 vtr(const LAS unsigned char* p) { typedef short v4i16_t __attribute__((ext_vector_type(4))); return __builtin_bit_cast(s16x4, __builtin_amdgcn_ds_read_tr16_b64_v4i16((LAS v4i16_t*)p)); }
__device__ __forceinline__ unsigned cvtpk(float lo, float hi) { return cvt_pk_visible(lo, hi); }

__device__ __forceinline__ void sb_unit(bf16_t* PM, int bh, int qb, LAS unsigned char* lds, bool dry) {
    int tid = threadIdx.x; asm volatile("" : "+v"(tid));
    const int lane = tid & 63, wave = __builtin_amdgcn_readfirstlane(tid >> 6), r = lane & 31, h = lane >> 5;
    const int b = bh >> 2, hh = bh & 3; const size_t mb = (size_t)b * S_;
    const int q0 = 256 * qb + 32 * wave;
    constexpr float C2 = 0.125f * 1.4426950408889634f;
    bf16x8 qf[4];
#pragma unroll
    for (int kk = 0; kk < 4; ++kk) { const u32x4 v = *(const u32x4*)(PM + (mb + q0 + r) * NPM + C_SQ + hh * 64 + 16 * kk + 8 * h); u32x4 w;
#pragma unroll
        for (int j = 0; j < 4; ++j) w[j] = cvtpk(__uint_as_float(v[j] << 16) * C2, __uint_as_float(v[j] & 0xffff0000u) * C2);
        qf[kk] = __builtin_bit_cast(bf16x8, w); }
    const int NT = 4 * qb + 4;
    const int srow = tid >> 3, sch = tid & 7;
    const bf16_t* sbase = PM + (mb + srow) * NPM + C_SK + hh * 64 + 8 * sch; const int swoff = rowoff(srow) + sch * 16;
    u32x4 sk, sv;
#define SB_LOAD(tl) do { const bf16_t* p_ = sbase + (size_t)(64 * (tl)) * NPM; sk = *(const u32x4*)p_; sv = *(const u32x4*)(p_ + (C_SV - C_SK)); } while (0)
#define SB_STORE(bs) do { *(LAS u32x4*)(lds + (bs) * 2 * TILEB + swoff) = sk; *(LAS u32x4*)(lds + (bs) * 2 * TILEB + TILEB + swoff) = sv; } while (0)
    const int kbase = rowoff(32 * ((r >> 2) & 1) + 4 * (r >> 3) + (r & 3)) + 16 * h;
    const int li = lane & 15;
    const int vbase = rowoff(32 * h + (li >> 2)) + (16 * ((lane >> 4) & 1) + 4 * (li & 3)) * 2;
    f32x16 o[2]; o[0] = (f32x16){}; o[1] = (f32x16){};
    float carry = 1.0f;
    volatile LAS unsigned* flg = (volatile LAS unsigned*)(lds + 4 * TILEB);
    __syncthreads();
    if (tid < 3) flg[tid] = 0u;
    SB_LOAD(NT - 1); SB_STORE(0);
    if (NT > 1) SB_LOAD(NT - 2);
    __syncthreads();
    for (int it = 0; it < NT; ++it) {
        const int tl = NT - 1 - it, bs = it & 1;
        if (it + 1 < NT) SB_STORE(bs ^ 1);
        if (it + 2 < NT) SB_LOAD(tl - 2);
        if (64 * tl <= q0 + 31) {
            const LAS unsigned char* Kb = lds + bs * 2 * TILEB; const LAS unsigned char* Vb = Kb + TILEB;
            f32x16 p0 = (f32x16){}, p1 = (f32x16){};
#pragma unroll
            for (int kk = 0; kk < 4; ++kk) {
                const bf16x8 a0 = *(const LAS bf16x8*)(Kb + kbase + kk * 32), a1 = *(const LAS bf16x8*)(Kb + kbase + 16 * ROWB + kk * 32);
                p0 = __builtin_amdgcn_mfma_f32_32x32x16_bf16(a0, qf[kk], p0, 0, 0, 0);
                p1 = __builtin_amdgcn_mfma_f32_32x32x16_bf16(a1, qf[kk], p1, 0, 0, 0);
            }
            if (64 * tl + 63 >= q0) {
                const int kq = 64 * tl + 32 * h - (q0 + r);
#pragma unroll
                for (int i = 0; i < 16; ++i) { if (kq + i >= 0) p0[i] = -INFINITY; if (kq + 16 + i >= 0) p1[i] = -INFINITY; }
            }
            float c = 1.0f;
#pragma unroll
            for (int i = 15; i >= 0; --i) { const float e = __builtin_amdgcn_exp2f(p1[i]); const float kp = __builtin_amdgcn_rcpf(1.0f + e); const float cn = c * kp; p1[i] = c - cn; c = cn; }
#pragma unroll
            for (int i = 15; i >= 0; --i) { const float e = __builtin_amdgcn_exp2f(p0[i]); const float kp = __builtin_amdgcn_rcpf(1.0f + e); const float cn = c * kp; p0[i] = c - cn; c = cn; }
            const auto rr = __builtin_amdgcn_permlane32_swap(__float_as_uint(c), __float_as_uint(c), false, false);
            const float c0 = h ? carry : carry * __uint_as_float(rr[1]);
            carry = carry * (__uint_as_float(rr[0]) * __uint_as_float(rr[1]));
            u32x4 bq[2][2];
#pragma unroll
            for (int s2 = 0; s2 < 2; ++s2)
#pragma unroll
                for (int j = 0; j < 4; ++j) { bq[0][s2][j] = cvtpk(p0[8 * s2 + 2 * j] * c0, p0[8 * s2 + 2 * j + 1] * c0); bq[1][s2][j] = cvtpk(p1[8 * s2 + 2 * j] * c0, p1[8 * s2 + 2 * j + 1] * c0); }
#pragma unroll
            for (int db = 0; db < 2; ++db)
#pragma unroll
                for (int p = 0; p < 2; ++p)
#pragma unroll
                    for (int s2 = 0; s2 < 2; ++s2) {
                        const s16x4 lo = vtr(Vb + vbase + (16 * p + 8 * s2) * ROWB + 64 * db), hi = vtr(Vb + vbase + (16 * p + 8 * s2 + 4) * ROWB + 64 * db);
                        const bf16x8 av = (bf16x8){lo[0], lo[1], lo[2], lo[3], hi[0], hi[1], hi[2], hi[3]};
                        o[db] = __builtin_amdgcn_mfma_f32_32x32x16_bf16(av, __builtin_bit_cast(bf16x8, bq[p][s2]), o[db], 0, 0, 0);
                    }
        }
        if (__any(carry != 0.0f) && lane == 0) flg[it % 3] = 1u;
        __syncthreads();
        const unsigned alive = flg[it % 3];
        if (tid == 0) flg[(it + 2) % 3] = 0u;
        if (!alive) break;
    }
#undef SB_LOAD
#undef SB_STORE
    if (!dry) {
        bf16_t* op = PM + (mb + q0 + r) * NPM + C_SQ + hh * 64 + 4 * h;
#pragma unroll
        for (int db = 0; db < 2; ++db)
#pragma unroll
            for (int g = 0; g < 4; ++g) { u32x2 w; w.x = cvtpk(o[db][4 * g], o[db][4 * g + 1]); w.y = cvtpk(o[db][4 * g + 2], o[db][4 * g + 3]); *(u32x2*)(op + 32 * db + 8 * g) = w; }
    }
}
__device__ __forceinline__ void sb_phase(bf16_t* PM, LAS unsigned char* lds, int bid, int G, bool dry) {
    for (int p = bid; p < 256; p += G) sb_unit(PM, p >> 5, p & 31, lds, dry);
    __syncthreads();
}
}

namespace cm {
typedef short bf16x8 __attribute__((ext_vector_type(8)));
typedef short s16x4 __attribute__((ext_vector_type(4)));
typedef float f32x16 __attribute__((ext_vector_type(16)));
typedef unsigned u32x4 __attribute__((ext_vector_type(4)));
typedef unsigned u32x2 __attribute__((ext_vector_type(2)));
constexpr int ROWB = 144, TB128 = 128 * ROWB + 16, TB64 = 64 * ROWB + 16;
__device__ __forceinline__ int rowoff(int row) { return row * ROWB + ((row >> 4) & 1) * 16; }
__device__ __forceinline__ s16x4 vtr(const LAS unsigned char* p) { typedef short v4i16_t __attribute__((ext_vector_type(4))); return __builtin_bit_cast(s16x4, __builtin_amdgcn_ds_read_tr16_b64_v4i16((LAS v4i16_t*)p)); }
__device__ __forceinline__ bf16x8 tr2(const LAS unsigned char* p) { const s16x4 lo = vtr(p), hi = vtr(p + 4 * ROWB); return (bf16x8){lo[0], lo[1], lo[2], lo[3], hi[0], hi[1], hi[2], hi[3]}; }
__device__ __forceinline__ unsigned cvtpk(float lo, float hi) { return cvt_pk_visible(lo, hi); }
__device__ __forceinline__ float lo16(unsigned v) { return __uint_as_float(v << 16); }
__device__ __forceinline__ float hi16(unsigned v) { return __uint_as_float(v & 0xffff0000u); }
__constant__ double INVF[32] = {1.0, 0.7498942093324559, 0.5623413251903491, 0.4216965034285822, 0.31622776601683794, 0.23713737056616552, 0.1778279410038923, 0.1333521432163324, 0.1, 0.07498942093324558, 0.05623413251903491, 0.042169650342858224, 0.03162277660168379, 0.023713737056616554, 0.01778279410038923, 0.01333521432163324, 0.01, 0.007498942093324558, 0.005623413251903491, 0.004216965034285823, 0.0031622776601683794, 0.0023713737056616554, 0.0017782794100389228, 0.001333521432163324, 0.001, 0.0007498942093324559, 0.0005623413251903491, 0.00042169650342858224, 0.00031622776601683794, 0.00023713737056616554, 0.00017782794100389227, 0.0001333521432163324};
__device__ __forceinline__ float ret_lg2(int h) { return log2f(1.0f - exp2f(-(5.0f + (float)h))); }

struct Lanes { int lane, wave, sub, wq, r, h, kfrag, tr16, tr8; };
__device__ __forceinline__ Lanes lanes() {
    Lanes L; int tid = threadIdx.x; asm volatile("" : "+v"(tid));
    L.lane = tid & 63; L.wave = __builtin_amdgcn_readfirstlane(tid >> 6); L.sub = L.wave >> 2; L.wq = L.wave & 3; L.r = L.lane & 31; L.h = L.lane >> 5;
    const int li = L.lane & 15, cb = 2 * (16 * ((L.lane >> 4) & 1) + 4 * (li & 3));
    L.kfrag = rowoff(16 * ((L.r >> 2) & 1) + 4 * (L.r >> 3) + (L.r & 3)) + 16 * L.h;
    L.tr16 = rowoff(16 * L.h + (li >> 2)) + cb;
    L.tr8 = rowoff(8 * L.h + (li >> 2)) + cb;
    return L;
}
#define CM_TR8(T, kk, col0) cm::tr2((T) + L.tr8 + (kk) * 16 * cm::ROWB + ((kk) & 1) * 16 + 2 * (col0))
#define CM_TR16(T, row0, s, col0) cm::tr2((T) + L.tr16 + ((row0) + 8 * (s)) * cm::ROWB + 2 * (col0))

__device__ __forceinline__ void stage_rot(const bf16_t* src, const float (&cs)[8], const float (&sn)[8], float scale, LAS unsigned char* T, int row, int c) {
    const u32x4 lo = *(const u32x4*)src, hi = *(const u32x4*)(src + 32); u32x4 olo, ohi;
#pragma unroll
    for (int j = 0; j < 4; ++j) { const float x1a = lo16(lo[j]), x1b = hi16(lo[j]), x2a = lo16(hi[j]), x2b = hi16(hi[j]);
        olo[j] = cvtpk((x1a * cs[2 * j] - x2a * sn[2 * j]) * scale, (x1b * cs[2 * j + 1] - x2b * sn[2 * j + 1]) * scale);
        ohi[j] = cvtpk((x1a * sn[2 * j] + x2a * cs[2 * j]) * scale, (x1b * sn[2 * j + 1] + x2b * cs[2 * j + 1]) * scale); }
    *(LAS u32x4*)(T + rowoff(row) + 16 * c) = olo; *(LAS u32x4*)(T + rowoff(row) + 16 * (c + 4)) = ohi;
}
__device__ __forceinline__ void rot_angles(const int* pos, size_t m, int c, float (&cs)[8], float (&sn)[8]) {
    const double p = (double)pos[m];
#pragma unroll
    for (int e = 0; e < 8; ++e) { double ang = p * INVF[8 * c + e]; ang -= 6.283185307179586 * rint(ang * 0.15915494309189535); sincosf((float)ang, &sn[e], &cs[e]); }
}
__device__ __forceinline__ void ret_local_unit(int u2, const bf16_t* PM, const int* pos, float* RL, LAS unsigned char* lds) {
    const Lanes L = lanes(); const int tid = L.wave * 64 + L.lane;
    const int b = u2 >> 7, hp = (u2 >> 6) & 1, n = u2 & 63; const size_t m0 = (size_t)b * S_ + 128 * n;
    __syncthreads();
    { const int row = tid >> 2, c = tid & 3; float cs[8], sn[8]; rot_angles(pos, m0 + row, c, cs, sn);
#pragma unroll
      for (int sub = 0; sub < 2; ++sub) { const int hd = 2 * hp + sub;
          stage_rot(PM + (m0 + row) * NPM + C_RK + hd * 64 + 8 * c, cs, sn, 0.125f * exp2f(-(float)row * ret_lg2(hd)), lds + sub * 2 * TB128, row, c); }
#pragma unroll
      for (int i = 0; i < 2; ++i) { const int it = tid + 512 * i, vr = it >> 3, ch = it & 7;
#pragma unroll
          for (int sub = 0; sub < 2; ++sub) *(LAS u32x4*)(lds + sub * 2 * TB128 + TB128 + rowoff(vr) + 16 * ch) = *(const u32x4*)(PM + (m0 + vr) * NPM + C_RV + (2 * hp + sub) * 64 + 8 * ch); } }
    __syncthreads();
    const LAS unsigned char* Kt = lds + L.sub * 2 * TB128; const LAS unsigned char* Vt = Kt + TB128;
    const int dkb = L.wq >> 1, dvb = L.wq & 1, hd = 2 * hp + L.sub;
    f32x16 acc = (f32x16){};
#pragma unroll
    for (int kk = 0; kk < 8; ++kk) acc = __builtin_amdgcn_mfma_f32_32x32x16_bf16(CM_TR8(Kt, kk, 32 * dkb), CM_TR8(Vt, kk, 32 * dvb), acc, 0, 0, 0);
    const float g127 = exp2f(127.0f * ret_lg2(hd));
    float* dst = RL + ((size_t)((b * 4 + hd) * NCH + n)) * 4096 + 32 * dvb + L.r;
#pragma unroll
    for (int i = 0; i < 16; ++i) dst[(32 * dkb + (i & 3) + 8 * (i >> 2) + 4 * L.h) * 64] = acc[i] * g127;
}
__device__ __forceinline__ void ret_out_unit(int u2, bf16_t* PM, const int* pos, const float* RL, const float* ret_g, LAS unsigned char* lds, bool dry) {
    const Lanes L = lanes(); const int tid = L.wave * 64 + L.lane;
    const int b = u2 >> 7, hp = (u2 >> 6) & 1, n = u2 & 63; const size_t m0 = (size_t)b * S_ + 128 * n;
    constexpr int SUBB = 3 * TB128 + TB64;
    __syncthreads();
    { const int row = tid >> 2, c = tid & 3; float cs[8], sn[8]; rot_angles(pos, m0 + row, c, cs, sn);
#pragma unroll
      for (int sub = 0; sub < 2; ++sub) { const int hd = 2 * hp + sub; const float lg = ret_lg2(hd);
          stage_rot(PM + (m0 + row) * NPM + C_RQ + hd * 64 + 8 * c, cs, sn, exp2f((float)row * lg), lds + sub * SUBB, row, c);
          stage_rot(PM + (m0 + row) * NPM + C_RK + hd * 64 + 8 * c, cs, sn, 0.125f * exp2f(-(float)row * lg), lds + sub * SUBB + TB128, row, c); }
#pragma unroll
      for (int i = 0; i < 2; ++i) { const int it = tid + 512 * i, vr = it >> 3, ch = it & 7;
#pragma unroll
          for (int sub = 0; sub < 2; ++sub) *(LAS u32x4*)(lds + sub * SUBB + 2 * TB128 + rowoff(vr) + 16 * ch) = *(const u32x4*)(PM + (m0 + vr) * NPM + C_RV + (2 * hp + sub) * 64 + 8 * ch); }
      { const int dk = tid >> 3, ch = tid & 7;
#pragma unroll
        for (int sub = 0; sub < 2; ++sub) { const int hd = 2 * hp + sub; const float g = exp2f(ret_lg2(hd));
            const float* sp = RL + ((size_t)((b * 4 + hd) * NCH + n)) * 4096 + dk * 64 + 8 * ch; const float4 s0 = *(const float4*)sp, s1 = *(const float4*)(sp + 4);
            u32x4 w; w[0] = cvtpk(s0.x * g, s0.y * g); w[1] = cvtpk(s0.z * g, s0.w * g); w[2] = cvtpk(s1.x * g, s1.y * g); w[3] = cvtpk(s1.z * g, s1.w * g);
            *(LAS u32x4*)(lds + sub * SUBB + 3 * TB128 + rowoff(dk) + 16 * ch) = w; } } }
    __syncthreads();
    const LAS unsigned char* Qt = lds + L.sub * SUBB; const LAS unsigned char* Kt = Qt + TB128; const LAS unsigned char* Vt = Kt + TB128; const LAS unsigned char* St = Vt + TB128;
    const int hd = 2 * hp + L.sub, wq = L.wq;
    bf16x8 qf[4];
#pragma unroll
    for (int kk = 0; kk < 4; ++kk) qf[kk] = *(const LAS bf16x8*)(Qt + rowoff(32 * wq + L.r) + 16 * L.h + 32 * kk);
    f32x16 o[2]; o[0] = (f32x16){}; o[1] = (f32x16){};
    for (int j = 0; j <= wq; ++j) {
        f32x16 p = (f32x16){};
#pragma unroll
        for (int kk = 0; kk < 4; ++kk) p = __builtin_amdgcn_mfma_f32_32x32x16_bf16(*(const LAS bf16x8*)(Kt + L.kfrag + 32 * j * ROWB + 32 * kk), qf[kk], p, 0, 0, 0);
        if (j == wq) {
#pragma unroll
            for (int i = 0; i < 16; ++i) if (16 * L.h + i > L.r) p[i] = 0.f;
        }
        u32x4 bq[2];
#pragma unroll
        for (int s = 0; s < 2; ++s)
#pragma unroll
            for (int t = 0; t < 4; ++t) bq[s][t] = cvtpk(p[8 * s + 2 * t], p[8 * s + 2 * t + 1]);
#pragma unroll
        for (int db = 0; db < 2; ++db)
#pragma unroll
            for (int s = 0; s < 2; ++s) o[db] = __builtin_amdgcn_mfma_f32_32x32x16_bf16(CM_TR16(Vt, 32 * j, s, 32 * db), __builtin_bit_cast(bf16x8, bq[s]), o[db], 0, 0, 0);
    }
#pragma unroll
    for (int db = 0; db < 2; ++db)
#pragma unroll
        for (int kk = 0; kk < 4; ++kk) o[db] = __builtin_amdgcn_mfma_f32_32x32x16_bf16(CM_TR8(St, kk, 32 * db), qf[kk], o[db], 0, 0, 0);
    float ss = 0.f;
#pragma unroll
    for (int db = 0; db < 2; ++db)
#pragma unroll
        for (int i = 0; i < 16; ++i) ss += o[db][i] * o[db][i];
    ss += __shfl_xor(ss, 32);
    const float rstd = 1.0f / sqrtf(ss * (1.0f / 64.0f) + 1e-6f);
    bf16_t* op = PM + (m0 + 32 * wq + L.r) * NPM + C_RG + hd * 64 + 4 * L.h; const float* gp = ret_g + hd * 64 + 4 * L.h;
#pragma unroll
    for (int db = 0; db < 2; ++db)
#pragma unroll
        for (int g = 0; g < 4; ++g) { const u32x2 gate = *(const u32x2*)(op + 32 * db + 8 * g); const float4 rg4 = *(const float4*)(gp + 32 * db + 8 * g);
            const float gv[4] = {lo16(gate.x), hi16(gate.x), lo16(gate.y), hi16(gate.y)}, rw[4] = {rg4.x, rg4.y, rg4.z, rg4.w}; float v[4];
#pragma unroll
            for (int t = 0; t < 4; ++t) v[t] = o[db][4 * g + t] * rstd * rw[t] * gv[t] / (1.0f + __expf(-gv[t]));
            u32x2 w; w.x = cvtpk(v[0], v[1]); w.y = cvtpk(v[2], v[3]); if (!dry) *(u32x2*)(op + 32 * db + 8 * g) = w; }
}
__device__ __forceinline__ void scan_phase(float* CL, float* RL, float* SM, int gtid, int NT) {
    for (int it = gtid; it < 32768 + 512 + 32768; it += NT) {
        if (it < 32768 + 512) {
            const bool isn = it >= 32768; const int bh = isn ? (it - 32768) >> 6 : it >> 12, e = isn ? (it - 32768) & 63 : it & 4095;
            float* base = isn ? SM + SM_NL + (size_t)bh * NCH * 64 + e : CL + (size_t)bh * NCH * 4096 + e; const int stride = isn ? 64 : 4096;
            float t[NCH];
#pragma unroll
            for (int n = 0; n < NCH; ++n) t[n] = base[(size_t)n * stride];
            float c = 0.f, m_st = 0.f;
#pragma unroll
            for (int n = 0; n < NCH; ++n) {
                const int u = bh * NCH + n;
                const float m_l = SM[SM_ML + u], a_l = SM[SM_AL + u];
                const float m_new = fmaxf(a_l + m_st, m_l), s_old = expf(a_l + m_st - m_new), s_new = expf(m_l - m_new);
                base[(size_t)n * stride] = c; c = s_old * c + s_new * t[n];
                if (!isn && e == 0) SM[SM_MI + u] = m_st;
                m_st = m_new;
            }
        } else {
            const int r = it - 32768 - 512, bh = r >> 12, e = r & 4095, h = bh & 3; const float dc = exp2f(128.0f * ret_lg2(h));
            float* base = RL + (size_t)bh * NCH * 4096 + e;
            float t[NCH];
#pragma unroll
            for (int n = 0; n < NCH; ++n) t[n] = base[(size_t)n * 4096];
            float c = 0.f;
#pragma unroll
            for (int n = 0; n < NCH; ++n) { base[(size_t)n * 4096] = c; c = dc * c + t[n]; }
        }
    }
}
}

namespace cm {
__device__ __forceinline__ float logsig(float x) { return fminf(x, 0.0f) - log1pf(__expf(-fabsf(x))); }
__device__ __forceinline__ float wave_scan_add(float v, int lane) {
#pragma unroll
    for (int o = 1; o < 64; o <<= 1) { const float t = __shfl_up(v, o); if (lane >= o) v += t; }
    return v;
}
__device__ __forceinline__ float wave_scan_max(float v, int lane) {
#pragma unroll
    for (int o = 1; o < 64; o <<= 1) { const float t = __shfl_up(v, o); if (lane >= o) v = fmaxf(v, t); }
    return v;
}
__device__ __forceinline__ float wave_max(float v) {
#pragma unroll
    for (int o = 1; o < 64; o <<= 1) v = fmaxf(v, __shfl_xor(v, o));
    return v;
}
__device__ __forceinline__ void stage_conv(const bf16_t* src, int trow, const float* cw, const float* cb, int chan, float mult, LAS unsigned char* T, int row, int ch) {
    float acc[8]; { const float4 b0 = *(const float4*)(cb + chan), b1 = *(const float4*)(cb + chan + 4); acc[0] = b0.x; acc[1] = b0.y; acc[2] = b0.z; acc[3] = b0.w; acc[4] = b1.x; acc[5] = b1.y; acc[6] = b1.z; acc[7] = b1.w; }
#pragma unroll
    for (int j = 0; j < 4; ++j) {
        if (trow - 3 + j >= 0) {
            const u32x4 x = *(const u32x4*)(src + (ptrdiff_t)(j - 3) * NPM); const float4 w0 = *(const float4*)(cw + j * 512 + chan), w1 = *(const float4*)(cw + j * 512 + chan + 4);
            acc[0] += w0.x * lo16(x[0]); acc[1] += w0.y * hi16(x[0]); acc[2] += w0.z * lo16(x[1]); acc[3] += w0.w * hi16(x[1]);
            acc[4] += w1.x * lo16(x[2]); acc[5] += w1.y * hi16(x[2]); acc[6] += w1.z * lo16(x[3]); acc[7] += w1.w * hi16(x[3]);
        }
    }
    u32x4 o;
#pragma unroll
    for (int j = 0; j < 4; ++j) { const float v0 = acc[2 * j], v1 = acc[2 * j + 1]; o[j] = cvtpk(v0 / (1.0f + __expf(-v0)) * mult, v1 / (1.0f + __expf(-v1)) * mult); }
    *(LAS u32x4*)(T + rowoff(row) + 16 * ch) = o;
}
__device__ __forceinline__ void ml_local_unit(int u2, const bf16_t* PM, const float* IF, const float* cw, const float* cb, float* CL, float* SM, LAS unsigned char* lds) {
    const Lanes L = lanes(); const int tid = L.wave * 64 + L.lane;
    const int b = u2 >> 7, hp = (u2 >> 6) & 1, n = u2 & 63; const size_t m0 = (size_t)b * S_ + 128 * n;
    const int t = tid & 255, ts = tid >> 8, thd = 2 * hp + ts;
    LAS float* sc = (LAS float*)(lds + 4 * TB128) + ts * 512;
    __syncthreads();
    float a_row = 0.f, g_row = -INFINITY, m_loc = 0.f, a_last = 0.f;
    if (t < 128) { a_row = wave_scan_add(logsig(IF[(m0 + t) * 8 + 4 + thd]), L.lane); if (t == 63) sc[0] = a_row; }
    __syncthreads();
    if (t < 128) { if (t >= 64) a_row += sc[0]; if (t == 127) sc[1] = a_row; }
    __syncthreads();
    if (t < 128) { a_last = sc[1]; g_row = a_last - a_row + IF[(m0 + t) * 8 + thd]; const float mw = wave_max(g_row); if ((t & 63) == 0) sc[2 + (t >> 6)] = mw; }
    __syncthreads();
    if (t < 128) { m_loc = fmaxf(sc[2], sc[3]); sc[256 + t] = __expf(g_row - m_loc); }
    __syncthreads();
#pragma unroll
    for (int i = 0; i < 2; ++i) { const int it = tid + 512 * i, row = it >> 3, ch = it & 7;
#pragma unroll
        for (int sub = 0; sub < 2; ++sub) { const int hd = 2 * hp + sub; const float w = ((LAS float*)(lds + 4 * TB128))[sub * 512 + 256 + row];
            stage_conv(PM + (m0 + row) * NPM + C_MK + hd * 64 + 8 * ch, 128 * n + row, cw, cb, 256 + hd * 64 + 8 * ch, w, lds + sub * 2 * TB128, row, ch);
            *(LAS u32x4*)(lds + sub * 2 * TB128 + TB128 + rowoff(row) + 16 * ch) = *(const u32x4*)(PM + (m0 + row) * NPM + C_MV + hd * 64 + 8 * ch); } }
    __syncthreads();
    const LAS unsigned char* Kt = lds + L.sub * 2 * TB128; const LAS unsigned char* Vt = Kt + TB128;
    const int dkb = L.wq >> 1, dvb = L.wq & 1, hd = 2 * hp + L.sub; const int u = (b * 4 + hd) * NCH + n;
    f32x16 acc = (f32x16){}, accn = (f32x16){};
    const bf16x8 ones = (bf16x8){0x3f80, 0x3f80, 0x3f80, 0x3f80, 0x3f80, 0x3f80, 0x3f80, 0x3f80};
#pragma unroll
    for (int kk = 0; kk < 8; ++kk) { const bf16x8 kf = CM_TR8(Kt, kk, 32 * dkb); acc = __builtin_amdgcn_mfma_f32_32x32x16_bf16(kf, CM_TR8(Vt, kk, 32 * dvb), acc, 0, 0, 0);
        if (dvb == 0) accn = __builtin_amdgcn_mfma_f32_32x32x16_bf16(kf, ones, accn, 0, 0, 0); }
    float* dst = CL + (size_t)u * 4096 + 32 * dvb + L.r;
#pragma unroll
    for (int i = 0; i < 16; ++i) dst[(32 * dkb + (i & 3) + 8 * (i >> 2) + 4 * L.h) * 64] = acc[i];
    if (dvb == 0 && L.r == 0) {
#pragma unroll
        for (int i = 0; i < 16; ++i) SM[SM_NL + u * 64 + 32 * dkb + (i & 3) + 8 * (i >> 2) + 4 * L.h] = accn[i]; }
    if (t == 0) { const int uu = (b * 4 + thd) * NCH + n; SM[SM_ML + uu] = m_loc; SM[SM_AL + uu] = a_last; }
}
__device__ __forceinline__ void ml_out_unit(int u2, bf16_t* PM, const float* IF, const float* cw, const float* cb, const float* CL, const float* SM, LAS unsigned char* lds, bool dry) {
    const Lanes L = lanes(); const int tid = L.wave * 64 + L.lane;
    const int b = u2 >> 7, hp = (u2 >> 6) & 1, n = u2 & 63; const size_t m0 = (size_t)b * S_ + 128 * n;
    constexpr int SUBB = 3 * TB128 + TB64, SCB = 2304;
    const int t = tid & 255, ts = tid >> 8, thd = 2 * hp + ts; const int tu = (b * 4 + thd) * NCH + n;
    LAS float* sc = (LAS float*)(lds + 2 * SUBB + ts * SCB);
    LAS float* tmp = (LAS float*)(lds + 2 * SUBB + 2 * SCB) + ts * 256;
    __syncthreads();
    if (t < 128) tmp[t] = logsig(IF[(m0 + t) * 8 + 4 + thd]);
#pragma unroll
    for (int i = 0; i < 2; ++i) { const int it = tid + 512 * i, row = it >> 3, ch = it & 7;
#pragma unroll
        for (int sub = 0; sub < 2; ++sub) { const int hd = 2 * hp + sub;
            stage_conv(PM + (m0 + row) * NPM + C_MQ + hd * 64 + 8 * ch, 128 * n + row, cw, cb, hd * 64 + 8 * ch, 0.125f, lds + sub * SUBB, row, ch);
            stage_conv(PM + (m0 + row) * NPM + C_MK + hd * 64 + 8 * ch, 128 * n + row, cw, cb, 256 + hd * 64 + 8 * ch, 1.0f, lds + sub * SUBB + TB128, row, ch);
            *(LAS u32x4*)(lds + sub * SUBB + 2 * TB128 + rowoff(row) + 16 * ch) = *(const u32x4*)(PM + (m0 + row) * NPM + C_MV + hd * 64 + 8 * ch); } }
    { const int dk = tid >> 3, ch = tid & 7;
#pragma unroll
      for (int sub = 0; sub < 2; ++sub) { const int hd = 2 * hp + sub;
          const float* sp = CL + ((size_t)((b * 4 + hd) * NCH + n)) * 4096 + dk * 64 + 8 * ch; const float4 s0 = *(const float4*)sp, s1 = *(const float4*)(sp + 4);
          u32x4 w; w[0] = cvtpk(s0.x, s0.y); w[1] = cvtpk(s0.z, s0.w); w[2] = cvtpk(s1.x, s1.y); w[3] = cvtpk(s1.z, s1.w);
          *(LAS u32x4*)(lds + sub * SUBB + 3 * TB128 + rowoff(dk) + 16 * ch) = w; } }
    if (t < 32) { const float2 nv = *(const float2*)(SM + SM_NL + tu * 64 + 2 * t); ((LAS unsigned*)(sc + 512))[t] = cvtpk(nv.x, nv.y); }
    __syncthreads();
    float a_row = 0.f, bb_row = -INFINITY, cm_row = -INFINITY;
    if (t < 128) { a_row = wave_scan_add(tmp[t], L.lane); if (t == 63) tmp[128] = a_row; }
    __syncthreads();
    if (t < 128) { if (t >= 64) a_row += tmp[128]; bb_row = IF[(m0 + t) * 8 + thd] - a_row; sc[t] = bb_row; cm_row = wave_scan_max(bb_row, L.lane); if (t == 63) tmp[129] = cm_row; }
    __syncthreads();
    if (t < 128) { if (t >= 64) cm_row = fmaxf(cm_row, tmp[129]); const float m_in = SM[SM_MI + tu];
        const float m_inter = a_row + m_in, m_tot = fmaxf(m_inter, a_row + cm_row); sc[128 + t] = a_row - m_tot; sc[256 + t] = __expf(m_inter - m_tot); sc[384 + t] = __expf(-m_tot); }
    __syncthreads();
    const LAS unsigned char* Qt = lds + L.sub * SUBB; const LAS unsigned char* Kt = Qt + TB128; const LAS unsigned char* Vt = Kt + TB128; const LAS unsigned char* Ct = Vt + TB128;
    const LAS float* scw = (const LAS float*)(lds + 2 * SUBB + L.sub * SCB);
    const int hd = 2 * hp + L.sub, wq = L.wq, ql = 32 * wq + L.r;
    const float rowA = scw[128 + ql], sint = scw[256 + ql], emt = scw[384 + ql];
    bf16x8 qf[4];
#pragma unroll
    for (int kk = 0; kk < 4; ++kk) qf[kk] = *(const LAS bf16x8*)(Qt + rowoff(ql) + 16 * L.h + 32 * kk);
    f32x16 o[2]; o[0] = (f32x16){}; o[1] = (f32x16){}; f32x16 o3 = (f32x16){};
#pragma unroll
    for (int kk = 0; kk < 4; ++kk) {
#pragma unroll
        for (int db = 0; db < 2; ++db) o[db] = __builtin_amdgcn_mfma_f32_32x32x16_bf16(CM_TR8(Ct, kk, 32 * db), qf[kk], o[db], 0, 0, 0);
        bf16x8 nf = (bf16x8){}; if (L.r == 0) nf = *(const LAS bf16x8*)((const LAS unsigned char*)(scw + 512) + 2 * (16 * kk + 8 * L.h));
        o3 = __builtin_amdgcn_mfma_f32_32x32x16_bf16(nf, qf[kk], o3, 0, 0, 0);
    }
    const float qn = __shfl(o3[0], L.r);
#pragma unroll
    for (int db = 0; db < 2; ++db)
#pragma unroll
        for (int i = 0; i < 16; ++i) o[db][i] *= sint;
    float psum = 0.f;
    for (int j = 0; j <= wq; ++j) {
        f32x16 p = (f32x16){};
#pragma unroll
        for (int kk = 0; kk < 4; ++kk) p = __builtin_amdgcn_mfma_f32_32x32x16_bf16(*(const LAS bf16x8*)(Kt + L.kfrag + 32 * j * ROWB + 32 * kk), qf[kk], p, 0, 0, 0);
        const LAS float* bbp = scw + 32 * j + 16 * L.h;
#pragma unroll
        for (int i = 0; i < 16; ++i) { float w = __expf(rowA + bbp[i]) * p[i]; if (j == wq && 16 * L.h + i > L.r) w = 0.f; p[i] = w; psum += w; }
        u32x4 bq[2];
#pragma unroll
        for (int s = 0; s < 2; ++s)
#pragma unroll
            for (int tt = 0; tt < 4; ++tt) bq[s][tt] = cvtpk(p[8 * s + 2 * tt], p[8 * s + 2 * tt + 1]);
#pragma unroll
        for (int db = 0; db < 2; ++db)
#pragma unroll
            for (int s = 0; s < 2; ++s) o[db] = __builtin_amdgcn_mfma_f32_32x32x16_bf16(CM_TR16(Vt, 32 * j, s, 32 * db), __builtin_bit_cast(bf16x8, bq[s]), o[db], 0, 0, 0);
    }
    psum += __shfl_xor(psum, 32);
    const float den = sint * qn + psum, dn = 1.0f / fmaxf(fabsf(den), emt);
    bf16_t* op = PM + (m0 + ql) * NPM + C_MO + hd * 64 + 4 * L.h;
#pragma unroll
    for (int db = 0; db < 2; ++db)
#pragma unroll
        for (int g = 0; g < 4; ++g) { const u32x2 gate = *(const u32x2*)(op + 32 * db + 8 * g);
            const float gv[4] = {lo16(gate.x), hi16(gate.x), lo16(gate.y), hi16(gate.y)}; float v[4];
#pragma unroll
            for (int tt = 0; tt < 4; ++tt) v[tt] = o[db][4 * g + tt] * dn / (1.0f + __expf(-gv[tt]));
            u32x2 w; w.x = cvtpk(v[0], v[1]); w.y = cvtpk(v[2], v[3]); if (!dry) *(u32x2*)(op + 32 * db + 8 * g) = w; }
}
}

namespace cm {
constexpr int TB256 = 256 * ROWB + 16;
__device__ __forceinline__ int t5_bucket(int rel) {
    const int n = rel > 0 ? rel : 0;
    if (n < 16) return n;
    const int large = 16 + (int)(logf((float)n / 16.0f) / 2.0794415416798357f * 16.0f);
    return large < 31 ? large : 31;
}
__device__ __forceinline__ void stage_norm(const bf16_t* src, bool live, const float* gain8, float mult, LAS unsigned char* dst) {
    u32x4 x = (u32x4){0u, 0u, 0u, 0u}; if (live) x = *(const u32x4*)src;
    float v[8]; float ss = 0.f;
#pragma unroll
    for (int j = 0; j < 4; ++j) { v[2 * j] = lo16(x[j]); v[2 * j + 1] = hi16(x[j]); ss += v[2 * j] * v[2 * j] + v[2 * j + 1] * v[2 * j + 1]; }
    ss += __shfl_xor(ss, 1); ss += __shfl_xor(ss, 2); ss += __shfl_xor(ss, 4);
    const float rs = mult / sqrtf(ss * (1.0f / 64.0f) + 1e-6f);
    const float4 g0 = *(const float4*)gain8, g1 = *(const float4*)(gain8 + 4);
    u32x4 o; o[0] = cvtpk(v[0] * rs * g0.x, v[1] * rs * g0.y); o[1] = cvtpk(v[2] * rs * g0.z, v[3] * rs * g0.w); o[2] = cvtpk(v[4] * rs * g1.x, v[5] * rs * g1.y); o[3] = cvtpk(v[6] * rs * g1.z, v[7] * rs * g1.w);
    *(LAS u32x4*)dst = o;
}
__device__ __forceinline__ void swa_unit(int u2, bf16_t* PM, const int* pos, const float* q_g, const float* k_g, const float* sinks, const float* rel_bias, LAS unsigned char* lds, bool dry) {
    const Lanes L = lanes(); const int tid = L.wave * 64 + L.lane;
    const int b = u2 >> 7, g = (u2 >> 6) & 1, nb = u2 & 63; const size_t mb = (size_t)b * S_; const int s0 = 128 * nb - 128;
    LAS unsigned char* Kt = lds; LAS unsigned char* Vt = lds + TB256; LAS unsigned char* Qt0 = lds + 2 * TB256;
    LAS int* posk = (LAS int*)(lds + 2 * TB256 + 2 * TB128); LAS float* tb = (LAS float*)(posk + 256);
    __syncthreads();
#pragma unroll
    for (int i = 0; i < 4; ++i) { const int it = tid + 512 * i, row = it >> 3, ch = it & 7; const int s = s0 + row; const bool live = s >= 0;
        const bf16_t* kp = PM + (mb + (live ? s : 0)) * NPM + C_AK + g * 64 + 8 * ch;
        stage_norm(kp, live, k_g + 8 * ch, 1.0f, Kt + rowoff(row) + 16 * ch);
        u32x4 vv = (u32x4){0u, 0u, 0u, 0u}; if (live) vv = *(const u32x4*)(kp + (C_AV - C_AK));
        *(LAS u32x4*)(Vt + rowoff(row) + 16 * ch) = vv; }
#pragma unroll
    for (int i = 0; i < 2; ++i) { const int it = tid + 512 * i, row = it >> 3, ch = it & 7;
#pragma unroll
        for (int sub = 0; sub < 2; ++sub) stage_norm(PM + (mb + 128 * nb + row) * NPM + C_AQ + (2 * g + sub) * 64 + 8 * ch, true, q_g + 8 * ch, 0.125f, Qt0 + sub * TB128 + rowoff(row) + 16 * ch); }
    if (tid < 256) { const int s = s0 + tid; posk[tid] = pos[mb + (s >= 0 ? s : 0)]; }
    { const int sub = tid >> 8, nn = tid & 255; tb[sub * 256 + nn] = rel_bias[t5_bucket(nn) * 4 + 2 * g + sub]; }
    __syncthreads();
    const int hq = 2 * g + L.sub, wq = L.wq, ql = 32 * wq + L.r, jq = 128 + ql;
    const LAS unsigned char* Qt = Qt0 + L.sub * TB128; const LAS float* tbh = tb + L.sub * 256;
    bf16x8 qf[4];
#pragma unroll
    for (int kk = 0; kk < 4; ++kk) qf[kk] = *(const LAS bf16x8*)(Qt + rowoff(ql) + 16 * L.h + 32 * kk);
    const int pq = posk[jq]; const float sink = sinks[hq];
    f32x16 p[5]; float mx = sink;
#pragma unroll
    for (int jj = 0; jj < 5; ++jj) {
        const int T = wq + jj; f32x16 acc = (f32x16){};
#pragma unroll
        for (int kk = 0; kk < 4; ++kk) acc = __builtin_amdgcn_mfma_f32_32x32x16_bf16(*(const LAS bf16x8*)(Kt + L.kfrag + 32 * T * ROWB + 32 * kk), qf[kk], acc, 0, 0, 0);
        const int jb0 = 32 * T + 16 * L.h;
#pragma unroll
        for (int i = 0; i < 16; ++i) { const int jb = jb0 + i, dist = jq - jb; int idx = pq - posk[jb]; idx = idx < 0 ? 0 : (idx > 255 ? 255 : idx);
            float z = acc[i] + tbh[idx]; if (!(dist >= 0 && dist < 128 && s0 + jb >= 0)) z = -INFINITY; acc[i] = z; mx = fmaxf(mx, z); }
        p[jj] = acc;
    }
    mx = fmaxf(mx, __shfl_xor(mx, 32));
    float den = 0.f;
#pragma unroll
    for (int jj = 0; jj < 5; ++jj)
#pragma unroll
        for (int i = 0; i < 16; ++i) { const float e = __expf(p[jj][i] - mx); p[jj][i] = e; den += e; }
    den += __shfl_xor(den, 32); den += __expf(sink - mx);
    f32x16 o[2]; o[0] = (f32x16){}; o[1] = (f32x16){};
#pragma unroll
    for (int jj = 0; jj < 5; ++jj) {
        const int T = wq + jj; u32x4 bq[2];
#pragma unroll
        for (int s = 0; s < 2; ++s)
#pragma unroll
            for (int tt = 0; tt < 4; ++tt) bq[s][tt] = cvtpk(p[jj][8 * s + 2 * tt], p[jj][8 * s + 2 * tt + 1]);
#pragma unroll
        for (int db = 0; db < 2; ++db)
#pragma unroll
            for (int s = 0; s < 2; ++s) o[db] = __builtin_amdgcn_mfma_f32_32x32x16_bf16(CM_TR16(Vt, 32 * T, s, 32 * db), __builtin_bit_cast(bf16x8, bq[s]), o[db], 0, 0, 0);
    }
    const float dn = 1.0f / den;
    bf16_t* op = PM + (mb + 128 * nb + ql) * NPM + C_AQ + hq * 64 + 4 * L.h;
#pragma unroll
    for (int db = 0; db < 2; ++db)
#pragma unroll
        for (int g4 = 0; g4 < 4; ++g4) { u32x2 w; w.x = cvtpk(o[db][4 * g4] * dn, o[db][4 * g4 + 1] * dn); w.y = cvtpk(o[db][4 * g4 + 2] * dn, o[db][4 * g4 + 3] * dn); if (!dry) *(u32x2*)(op + 32 * db + 8 * g4) = w; }
}
}

constexpr int N_PHASES = 2 + 9 * L_;
__global__ void __launch_bounds__(NTHR, 2) mega_fwd(Args a_unused) {
    extern __shared__ __attribute__((aligned(16))) unsigned char lds_raw[];
    LAS unsigned char* lds = (LAS unsigned char*)lds_raw;
    volatile LAS unsigned* MISC = (volatile LAS unsigned*)(lds + MISC_OFF);
    const int G0 = gridDim.x, bid0 = blockIdx.x;
#define PH_S() int bid = bid0, G = G0; asm volatile("" : "+s"(bid), "+s"(G));
#define PHASE_IDS() int tid = threadIdx.x; asm volatile("" : "+v"(tid)); const int lane = tid & 63, wave = __builtin_amdgcn_readfirstlane(tid >> 6); \
    const int gw = bid * NWAVES + wave, NGW = G * NWAVES, gtid = bid * NTHR + tid, NT = G * NTHR; (void)lane; (void)gw; (void)NGW; (void)gtid; (void)NT;
    for (int u = threadIdx.x; u < (LDS_BYTES - LDSCTL_OFF) / 4; u += NTHR) ((LAS unsigned*)(lds + LDSCTL_OFF))[u] = 0u;
    __syncthreads();
    const int ph_lo = kargs()->ph_lo, ph_hi = kargs()->ph_hi;
    XcdBarrier bar = xcd_barrier_post((unsigned*)(kargs()->ws + WS_CTL) + CW_BAR + kargs()->li * XCD_BAR_WORDS, MISC + 8);
#define IN(k) (ph_lo <= (k) && (k) < ph_hi)
#define SEAM(k) do { if (IN(k) && IN((k) + 1)) xcd_barrier(bar); } while (0)
#define WSP(T, off) ((T*)(ka->ws + (off)))
    const unsigned probe = (unsigned)kargs()->probe;
#define REPS(kind) (((probe >> (kind)) & 1u) ? 2 : 1)
    if (IN(0)) { { PH_S(); PHASE_IDS(); KArgs ka = kargs(); mod_phase(ka->c, ka->w_ada, WSP(float, WS_ST_ML), lds, bid, G, tid); }
        xcd_barrier(bar);
        { PH_S(); PHASE_IDS(); KArgs ka = kargs(); mod_reduce(WSP(float, WS_ST_ML), ka->b_ada, WSP(float, WS_MOD), gtid, NT); } }
    SEAM(0);
    if (IN(1)) for (int rep = REPS(1) + ((probe >> 3) & 1u); rep > 0; --rep) { PH_S(); PHASE_IDS(); KArgs ka = kargs(); const bool dry = rep > 1;
        if (!((probe >> 4) & 1u) || !dry) convert_weights(ka->w_in, ka->w_up, ka->w_out, ka->w_ff1, ka->w_ff2, ka->ws, 0, lds, gw, NGW, wave, lane, dry);
        gs_phase(ka->norm_g, WSP(float, WS_MOD), WSP(float, WS_GS), gtid, NT);
        xprep_phase(ka->x, ka->norm_g, WSP(float, WS_MOD), WSP(bf16_t, WS_H), WSP(float, WS_SSQ), gw, NGW, lane, dry); __syncthreads(); }
    SEAM(1);
    if ((probe >> 20) & 1u) { for (int q = 0; q < 40; ++q) xcd_barrier(bar); }

    for (int l = 0; l < L_; ++l) {
        const int pb = 2 + 9 * l;
        if (l > 0) { if (IN(pb + 0)) { PH_S(); PHASE_IDS(); KArgs ka = kargs(); convert_weights(ka->w_in, ka->w_up, ka->w_out, ka->w_ff1, ka->w_ff2, ka->ws, l, lds, gw, NGW, wave, lane); __syncthreads(); } SEAM(pb + 0); }
        if (IN(pb + 1)) for (int rep = REPS(2); rep > 0; --rep) { PH_S(); KArgs ka = kargs(); pg8::Gemm g{WSP(bf16_t, WS_H), WSP(bf16_t, WS_WIN)}; pg8::StaticOrder S; S.init(T_, NINP, G, bid);
            pg8::EpiIn E{ka->ws, ka->gate_b + l * 8, l}; pg8::gemm_phase<D_, D_>(lds, g, S, E); }
        SEAM(pb + 1);
        if (IN(pb + 2)) { PH_S(); KArgs ka = kargs();
            for (int rep = REPS(12); rep > 0; --rep) sbk::sb_phase(WSP(bf16_t, WS_PM), lds, bid, G, rep > 1);
            for (int rep = REPS(13); rep > 0; --rep) for (int u2 = bid; u2 < 256; u2 += G) cm::swa_unit(u2, WSP(bf16_t, WS_PM), ka->pos, ka->q_g + l * 64, ka->k_g + l * 64, ka->sinks + l * 4, ka->rel_bias, lds, rep > 1);
            for (int rep = REPS(14); rep > 0; --rep) for (int u2 = bid; u2 < 256; u2 += G) cm::ret_local_unit(u2, WSP(bf16_t, WS_PM), ka->pos, WSP(float, WS_ST_RT), lds);
            for (int rep = REPS(15); rep > 0; --rep) for (int u2 = bid; u2 < 256; u2 += G) cm::ml_local_unit(u2, WSP(bf16_t, WS_PM), WSP(float, WS_IF), ka->conv_w + (size_t)l * 4 * 512, ka->conv_b + (size_t)l * 512, WSP(float, WS_ST_ML), WSP(float, WS_SMALL), lds);
            __syncthreads();
        }
        SEAM(pb + 2);
        if (IN(pb + 3)) { PH_S(); PHASE_IDS(); KArgs ka = kargs(); cm::scan_phase(WSP(float, WS_ST_ML), WSP(float, WS_ST_RT), WSP(float, WS_SMALL), gtid, NT); }
        SEAM(pb + 3);
        if (IN(pb + 4)) for (int rep = REPS(6); rep > 0; --rep) { PH_S(); KArgs ka = kargs(); const bool dry = rep > 1;
            for (int u2 = bid; u2 < 256; u2 += G) cm::ret_out_unit(u2, WSP(bf16_t, WS_PM), ka->pos, WSP(float, WS_ST_RT), ka->ret_g + (size_t)l * 256, lds, dry);
            for (int u2 = bid; u2 < 256; u2 += G) cm::ml_out_unit(u2, WSP(bf16_t, WS_PM), WSP(float, WS_IF), ka->conv_w + (size_t)l * 4 * 512, ka->conv_b + (size_t)l * 512, WSP(float, WS_ST_ML), WSP(float, WS_SMALL), lds, dry);
            __syncthreads();
        }
        SEAM(pb + 4);
        if (IN(pb + 5)) for (int rep = REPS(7); rep > 0; --rep) { PH_S(); KArgs ka = kargs(); pg8::Gemm g{WSP(bf16_t, WS_PM), WSP(bf16_t, WS_WUP)}; pg8::UpOrder S; S.so.init(T_, D_, G, bid);
          pg8::EpiUp E{WSP(bf16_t, WS_H), WSP(u8, WS_GT), rep > 1}; pg8::gemm_phase<NPM, 256>(lds, g, S, E); }
        SEAM(pb + 5);
        if (IN(pb + 6)) for (int rep = REPS(8); rep > 0; --rep) { PH_S(); KArgs ka = kargs(); pg8::Gemm g{WSP(bf16_t, WS_H), WSP(bf16_t, WS_WOUT)}; pg8::StaticOrder S; S.init(T_, D_, G, bid);
          pg8::EpiRes E{(l == 0) ? ka->x : ka->out, ka->out, WSP(float, WS_MOD) + (size_t)l * B_ * 2 * 3072 + 2048, WSP(float, WS_GS) + (size_t)(l * 2 + 1) * B_ * 1024, WSP(bf16_t, WS_H2), WSP(float, WS_SSQ) + (size_t)(l * 2 + 1) * T_, rep > 1};
          pg8::gemm_phase<D_, D_>(lds, g, S, E); }
        SEAM(pb + 6);
        if (IN(pb + 7)) for (int rep = REPS(10); rep > 0; --rep) { PH_S(); KArgs ka = kargs(); pg8::Gemm g{WSP(bf16_t, WS_H2), WSP(bf16_t, WS_W1)}; pg8::StaticOrder S; S.init(T_, DFF, G, bid);
          pg8::EpiFF1 E{WSP(bf16_t, WS_HID), WSP(float, WS_SSQ) + (size_t)(l * 2 + 1) * T_, WSP(float, WS_BIAS) + (size_t)l * B_ * BSTR + NINP}; pg8::gemm_phase<D_, D_>(lds, g, S, E); }
        SEAM(pb + 7);
        if (IN(pb + 8)) for (int rep = REPS(11); rep > 0; --rep) { PH_S(); KArgs ka = kargs(); pg8::Gemm g{WSP(bf16_t, WS_HID), WSP(bf16_t, WS_W2)}; pg8::StaticOrder S; S.init(T_, D_, G, bid); const bool nxt = l + 1 < L_;
          pg8::EpiRes E{ka->out, ka->out, WSP(float, WS_MOD) + (size_t)l * B_ * 2 * 3072 + 3072 + 2048, nxt ? WSP(float, WS_GS) + (size_t)((l + 1) * 2 + 0) * B_ * 1024 : nullptr, WSP(bf16_t, WS_H), WSP(float, WS_SSQ) + (size_t)((l + 1) * 2 + 0) * T_, rep > 1};
          pg8::gemm_phase<DFF, DFF>(lds, g, S, E); }
        SEAM(pb + 8);
    }
}

extern "C" void kernel_launch(void* const* d_in, const int* in_sizes, int n_in, void* d_out, int out_size, void* d_ws, size_t ws_size, hipStream_t stream) {
    static int grid = 0;
    if (grid == 0) {
        int dev = 0, cus = 0;
        if (hipGetDevice(&dev) != hipSuccess || hipDeviceGetAttribute(&cus, hipDeviceAttributeMultiprocessorCount, dev) != hipSuccess) { fprintf(stderr, "kernel_launch: device query failed\n"); grid = -1; return; }
        if (hipFuncSetAttribute((const void*)mega_fwd, hipFuncAttributeMaxDynamicSharedMemorySize, LDS_BYTES) != hipSuccess) { fprintf(stderr, "kernel_launch: hipFuncSetAttribute failed\n"); grid = -1; return; }
        int per_cu = 0;
        if (hipOccupancyMaxActiveBlocksPerMultiprocessor(&per_cu, (const void*)mega_fwd, NTHR, LDS_BYTES) != hipSuccess || per_cu < 1) fprintf(stderr, "kernel_launch: occupancy query reports %d\n", per_cu);
        (void)hipGetLastError();
        grid = cus;
    }
    if (grid < 0) return;
    (void)hipMemsetAsync((char*)d_ws + WS_CTL, 0, CTL_ZERO_BYTES, stream);
    Args a{};
    a.x = (const float*)d_in[0]; a.c = (const float*)d_in[1]; a.pos = (const int*)d_in[2]; a.w_ada = (const float*)d_in[3]; a.b_ada = (const float*)d_in[4]; a.norm_g = (const float*)d_in[5];
    a.w_in = (const float*)d_in[6]; a.conv_w = (const float*)d_in[7]; a.conv_b = (const float*)d_in[8]; a.gate_b = (const float*)d_in[9]; a.ret_g = (const float*)d_in[10]; a.q_g = (const float*)d_in[11];
    a.k_g = (const float*)d_in[12]; a.sinks = (const float*)d_in[13]; a.rel_bias = (const float*)d_in[14]; a.w_up = (const float*)d_in[15]; a.w_out = (const float*)d_in[16]; a.w_ff1 = (const float*)d_in[17]; a.w_ff2 = (const float*)d_in[18];
    a.out = (float*)d_out; a.ws = (unsigned char*)d_ws;
    a.ph_lo = 0; a.ph_hi = N_PHASES; a.li = 0; a.probe = PROBE_MASK;
    hipLaunchKernelGGL(mega_fwd, dim3(grid), dim3(NTHR), LDS_BYTES, stream, a);
}
```
